# Optimizing an MI355X kernel written in HIP

```python
import jax, jax.numpy as jnp
from jax import lax
import numpy as np

D_MODEL = 1024
BATCH = 4
SEQ = 4096
DEPTH = 4

HEAD_DIM = 64
N_ATT_HEADS = 8
D_ATT = N_ATT_HEADS * HEAD_DIM
N_CONV_GROUPS = 4
D_CONV = N_CONV_GROUPS * HEAD_DIM
N_SGU_GROUPS = 4
D_SGU = N_SGU_GROUPS * HEAD_DIM
SGU_CHUNK = 128
Q_BLOCK = 128
CONV_WIDTH = 3
D_FF = 2816
N_BRANCHES = 3
RMS_EPS = 1e-6
LN_EPS = 1e-5
IN_WIDTHS = (D_ATT, D_ATT, D_ATT, N_ATT_HEADS, D_CONV, D_CONV, D_CONV, D_SGU, D_SGU, N_BRANCHES * D_MODEL)
IN_WIDTH = 3 * D_ATT + N_ATT_HEADS + 3 * D_CONV + 2 * D_SGU + N_BRANCHES * D_MODEL

kernel_name = "fox_shortconv_sgu_gated_hybrid"


def rms_norm(x, g):
    xf = x.astype(jnp.float32)
    y = xf * lax.rsqrt(jnp.mean(xf * xf, axis=-1, keepdims=True) + RMS_EPS)
    return (y * g.astype(jnp.float32)).astype(x.dtype)


def layer_norm(x, g, b):
    xf = x.astype(jnp.float32)
    mu = jnp.mean(xf, axis=-1, keepdims=True)
    xc = xf - mu
    var = jnp.mean(xc * xc, axis=-1, keepdims=True)
    y = xc * lax.rsqrt(var + LN_EPS) * g.astype(jnp.float32) + b.astype(jnp.float32)
    return y.astype(x.dtype)


def split_cols(h, widths):
    offs = np.cumsum(np.array(widths))[:-1].tolist()
    return jnp.split(h, offs, axis=-1)


def causal_dwconv(x, w):
    K = w.shape[0]
    S = x.shape[1]
    xp = jnp.pad(x, ((0, 0), (K - 1, 0), (0, 0)))
    y = xp[:, K - 1:K - 1 + S] * w[K - 1]
    for k in range(K - 1):
        y = y + xp[:, k:k + S] * w[k]
    return y


def fox_attention(q, k, v, logf):
    S = q.shape[1]
    scale = HEAD_DIM ** -0.5
    c = jnp.cumsum(logf, axis=1).transpose(0, 2, 1)
    outs = []
    for i in range(S // Q_BLOCK):
        q0 = i * Q_BLOCK
        q1 = q0 + Q_BLOCK
        s = jnp.einsum('bqhd,bkhd->bhqk', q[:, q0:q1], k[:, :q1]).astype(jnp.float32) * scale
        bias = c[:, :, q0:q1, None] - c[:, :, None, :q1]
        mask = jnp.arange(q0, q1)[:, None] >= jnp.arange(q1)[None, :]
        s = jnp.where(mask, s + bias, -jnp.inf)
        p = jax.nn.softmax(s, axis=-1).astype(v.dtype)
        outs.append(jnp.einsum('bhqk,bkhd->bqhd', p, v[:, :q1]))
    return jnp.concatenate(outs, axis=1)


def short_conv_mixer(b_gate, c_gate, h, conv_w):
    return b_gate * causal_dwconv(c_gate * h, conv_w)


def chunked_sgu(u, v, ln_g, ln_b, w_s, b_s):
    B_, S, _ = u.shape
    u = jax.nn.gelu(u, approximate=True)
    v = layer_norm(jax.nn.gelu(v, approximate=True), ln_g, ln_b)
    n = S // SGU_CHUNK
    vc = v.reshape(B_, n, SGU_CHUNK, N_SGU_GROUPS, HEAD_DIM)
    mask = jnp.tril(jnp.ones((SGU_CHUNK, SGU_CHUNK), w_s.dtype))
    mixed = jnp.einsum('gts,bnsgd->bntgd', w_s * mask, vc) + b_s.T[:, :, None]
    return u * mixed.reshape(B_, S, D_SGU)


def conv_gated_ffn(x, w_up, conv_w, w_down):
    h = causal_dwconv(x @ w_up, conv_w)
    a, b = jnp.split(h, 2, axis=-1)
    return (jax.nn.gelu(a, approximate=True) * b) @ w_down


def setup_inputs(seed: int = 0) -> dict:
    key = jax.random.key(seed)
    ks = jax.random.split(key, 24)
    f32 = jnp.float32

    def nrm(k, shape, scale):
        return jax.random.normal(k, shape, f32) * scale

    L = DEPTH
    return {
        "x": nrm(ks[0], (BATCH, SEQ, D_MODEL), 1.0),
        "pre_mix_g": 1.0 + nrm(ks[1], (L, D_MODEL), 0.02),
        "post_mix_g": 1.0 + nrm(ks[2], (L, D_MODEL), 0.02),
        "pre_ffn_g": 1.0 + nrm(ks[3], (L, D_MODEL), 0.02),
        "post_ffn_g": 1.0 + nrm(ks[4], (L, D_MODEL), 0.02),
        "w_in": nrm(ks[5], (L, D_MODEL, IN_WIDTH), D_MODEL ** -0.5),
        "b_forget": jnp.linspace(1.0, 6.0, N_ATT_HEADS, dtype=f32)[None, :] + nrm(ks[6], (L, N_ATT_HEADS), 0.1),
        "b_gate": nrm(ks[7], (L, N_BRANCHES, D_MODEL), 0.02),
        "conv_mix_w": nrm(ks[8], (L, CONV_WIDTH, D_CONV), CONV_WIDTH ** -0.5),
        "sgu_ln_g": 1.0 + nrm(ks[9], (L, D_SGU), 0.02),
        "sgu_ln_b": nrm(ks[10], (L, D_SGU), 0.02),
        "sgu_w": nrm(ks[11], (L, N_SGU_GROUPS, SGU_CHUNK, SGU_CHUNK), SGU_CHUNK ** -0.5),
        "sgu_b": 1.0 + nrm(ks[12], (L, N_SGU_GROUPS, SGU_CHUNK), 0.02),
        "w_branch_att": nrm(ks[13], (L, D_ATT, D_MODEL), D_ATT ** -0.5),
        "w_branch_conv": nrm(ks[14], (L, D_CONV, D_MODEL), D_CONV ** -0.5),
        "w_branch_sgu": nrm(ks[15], (L, D_SGU, D_MODEL), D_SGU ** -0.5),
        "w_out": nrm(ks[16], (L, D_MODEL, D_MODEL), D_MODEL ** -0.5),
        "w_ffn_up": nrm(ks[17], (L, D_MODEL, 2 * D_FF), D_MODEL ** -0.5),
        "conv_ffn_w": nrm(ks[18], (L, CONV_WIDTH, 2 * D_FF), CONV_WIDTH ** -0.5),
        "w_ffn_down": nrm(ks[19], (L, D_FF, D_MODEL), D_FF ** -0.5),
    }


def reference(x, pre_mix_g, post_mix_g, pre_ffn_g, post_ffn_g, w_in, b_forget, b_gate,
              conv_mix_w, sgu_ln_g, sgu_ln_b, sgu_w, sgu_b, w_branch_att, w_branch_conv,
              w_branch_sgu, w_out, w_ffn_up, conv_ffn_w, w_ffn_down):
    B_, S, D = x.shape
    for l in range(DEPTH):
        xn = rms_norm(x, pre_mix_g[l])
        h = xn @ w_in[l]
        q, k, v, f_logit, bg, cg, hc, u, vs, g_logit = split_cols(h, IN_WIDTHS)
        q = q.reshape(B_, S, N_ATT_HEADS, HEAD_DIM)
        k = k.reshape(B_, S, N_ATT_HEADS, HEAD_DIM)
        v = v.reshape(B_, S, N_ATT_HEADS, HEAD_DIM)
        logf = jax.nn.log_sigmoid((f_logit + b_forget[l]).astype(jnp.float32))
        y_att = fox_attention(q, k, v, logf).reshape(B_, S, D_ATT) @ w_branch_att[l]
        y_conv = short_conv_mixer(bg, cg, hc, conv_mix_w[l]) @ w_branch_conv[l]
        y_sgu = chunked_sgu(u, vs, sgu_ln_g[l], sgu_ln_b[l], sgu_w[l], sgu_b[l]) @ w_branch_sgu[l]
        gates = jax.nn.sigmoid(g_logit.reshape(B_, S, N_BRANCHES, D) + b_gate[l])
        merged = gates[:, :, 0] * y_att + gates[:, :, 1] * y_conv + gates[:, :, 2] * y_sgu
        x = x + rms_norm(merged @ w_out[l], post_mix_g[l])
        xn = rms_norm(x, pre_ffn_g[l])
        x = x + rms_norm(conv_gated_ffn(xn, w_ffn_up[l], conv_ffn_w[l], w_ffn_down[l]), post_ffn_g[l])
    return x
```

```cpp
#include <hip/hip_runtime.h>
#include <hip/hip_cooperative_groups.h>
#include <cstdio>
#include <cstdint>
namespace cg = cooperative_groups;

#define LAS __attribute__((address_space(3)))
typedef unsigned short bf16_t;
typedef short bf16x8 __attribute__((ext_vector_type(8)));
typedef float f32x4 __attribute__((ext_vector_type(4)));
typedef float f32x16 __attribute__((ext_vector_type(16)));
typedef unsigned u32x4 __attribute__((ext_vector_type(4)));
typedef unsigned u32x2 __attribute__((ext_vector_type(2)));
typedef float f32x2_t __attribute__((ext_vector_type(2)));
typedef __bf16 bf16x2_t __attribute__((ext_vector_type(2)));

constexpr int DM = 1024, SEQ = 4096, NB = 4, M = NB * SEQ, DEPTH = 4;
constexpr int INW = 5896;
constexpr int HW = 5888;
constexpr int DFF = 2816, DFF2 = 5632;
constexpr int C_Q = 0, C_K = 512, C_V = 1024, C_BG = 1536, C_CG = 1792, C_HC = 2048, C_U = 2304, C_VS = 2560, C_GATE = 2816;
constexpr float LOG2E = 1.4426950408889634f;
constexpr float QSCALE = 0.125f * LOG2E;

constexpr size_t MiB = 1u << 20;
constexpr size_t WS_LF = 1 * MiB;
constexpr size_t WS_RS = 1 * MiB + 512 * 1024;
constexpr size_t WS_CNT = 128 * 1024;
constexpr size_t WS_X1 = 512 * 1024, WS_X2 = 768 * 1024;
constexpr size_t WS_WFG = 1 * MiB + 768 * 1024;
constexpr size_t WS_WIN = 2 * MiB;
constexpr size_t WS_WBR = 14 * MiB;
constexpr size_t WS_WOUT = 16 * MiB;
constexpr size_t WS_WUP = 18 * MiB;
constexpr size_t WS_WDN = 29 * MiB;
constexpr size_t WS_WM = 35 * MiB;
constexpr size_t WS_XN = 36 * MiB;
constexpr size_t WS_Y = 68 * MiB;
constexpr size_t WS_MG = 100 * MiB;
constexpr size_t WS_ACT = 68 * MiB;
constexpr size_t WS_VT = 132 * MiB;
constexpr size_t WS_H = 156 * MiB;
constexpr size_t WS_HALO = 340 * MiB;
constexpr size_t WS_FFN2 = 344 * MiB;
constexpr size_t WS_FFN_BYTES = 35 * MiB + 128 * 1024 - 18 * MiB;
constexpr size_t WS_END = 362 * MiB;

constexpr int LDS_BYTES = 147456;

__device__ __forceinline__ unsigned pk2(float lo, float hi) { f32x2_t v = {lo, hi}; bf16x2_t b = __builtin_convertvector(v, bf16x2_t); return __builtin_bit_cast(unsigned, b); }
__device__ __forceinline__ float bflo(unsigned w) { return __builtin_bit_cast(float, w << 16); }
__device__ __forceinline__ float bfhi(unsigned w) { return __builtin_bit_cast(float, w & 0xffff0000u); }
__device__ __forceinline__ float gelu_t(float x) { const float u = x * (1.f + 0.044715f * x * x); const float e = __builtin_amdgcn_exp2f(-2.3022081981f * u); return x * __builtin_amdgcn_rcpf(1.f + e); }
__device__ __forceinline__ float inv_sigmoid_f(float z) { return fminf(1.f + __builtin_amdgcn_exp2f(-LOG2E * z), 1e6f); }
__device__ __forceinline__ float sigmoid_f(float z) { return __builtin_amdgcn_rcpf(1.f + __builtin_amdgcn_exp2f(-LOG2E * z)); }
__device__ __forceinline__ float wave_sum(float v) {
#pragma unroll
    for (int o = 1; o < 64; o <<= 1) v += __shfl_xor(v, o);
    return v;
}
__device__ __forceinline__ void unpack8(u32x4 w, float* f) { f[0] = bflo(w.x); f[1] = bfhi(w.x); f[2] = bflo(w.y); f[3] = bfhi(w.y); f[4] = bflo(w.z); f[5] = bfhi(w.z); f[6] = bflo(w.w); f[7] = bfhi(w.w); }

__device__ __forceinline__ int ltid() { int t = threadIdx.x; asm volatile("" : "+v"(t)); return t; }
template <class T> __device__ __forceinline__ T* launder(T* p) { asm volatile("" : "+s"(p)); return p; }

namespace pg8 {
constexpr int BM = 256, BK = 64, HALF = 128, HTB = HALF * BK * 2, STAGE_BYTES = 8 * HTB, NXCD = 8, WGM = 8;
__host__ __device__ __forceinline__ int lds_byte(int r, int c) { const int st = (r >> 4) * 2 + (c >> 5), rr = r & 15, cc = c & 31, ob = rr * 64 + cc * 2; return st * 1024 + (ob ^ (((ob >> 9) & 1) << 5)); }
__host__ __device__ __forceinline__ void stage_rc(int b, int& R, int& C) { const int st = b / 1024, sb = b % 1024, swz = sb ^ (((sb >> 9) & 1) << 5); R = (st >> 1) * 16 + swz / 64; C = (st & 1) * 32 + (swz % 64) / 2; }
__host__ __device__ __forceinline__ int perm32(int rho) { const int n = rho >> 4, i = rho & 15; return 8 * (i >> 2) + 4 * n + (i & 3); }

struct Unit { const char* a; const char* b; int nt, pm, pn, kind; };

__device__ __forceinline__ void order_map(int L, int nM, int nN, int& pm, int& pn) {
    const int nwg = nM * nN; int wgid = L;
    { const int q = nwg / NXCD, r = nwg % NXCD, xcd = wgid % NXCD, off = wgid / NXCD; wgid = (xcd < r ? xcd * (q + 1) : r * (q + 1) + (xcd - r) * q) + off; }
    const int nig = WGM * nN, gid = wgid / nig, fm = gid * WGM, gsz = (nM - fm) < WGM ? (nM - fm) : WGM;
    pm = fm + ((wgid % nig) % gsz); pn = (wgid % nig) / gsz;
}

template <class Epi, class Sched, bool ALIGN_EPI, bool APERM = false>
__device__ __forceinline__ void gemm_phase(LAS unsigned char* lds, const int lda, const int ldb, const Sched& S, const Epi& E) {
    const int tid = ltid(), wid = __builtin_amdgcn_readfirstlane(tid >> 6), lane = tid & 63, wr = wid >> 2, wc = wid & 3, fr = lane & 15, fq = lane >> 4;
    unsigned voffA[2], voffA1[2], voffB[2];
#pragma unroll
    for (int i = 0; i < 2; ++i) { int R, C; stage_rc(tid * 16 + i * 8192, R, C); const int Rb = (R & ~31) + perm32(R & 31);
        const int T0 = 8 * (16 * (R >> 6) + (R & 15)) + ((R >> 4) & 3);
        voffA[i] = (unsigned)((APERM ? T0 : R) * lda + C) * 2u; voffA1[i] = (unsigned)((APERM ? T0 + 4 : R) * lda + C) * 2u; voffB[i] = (unsigned)(Rb * ldb + C) * 2u; }
#define PG8_AH(ptr) (APERM ? (ptr) : (ptr) + hstepA)
    const size_t kstep = (size_t)(BK * 2);
    const size_t hstepA = (size_t)HALF * lda * 2, hstepB = (size_t)HALF * ldb * 2;
    const unsigned ldsw = (unsigned)wid * 1024u;
    const int aoff = lds_byte(wr * 64 + fr, fq * 8), boff = lds_byte(wc * 32 + fr, fq * 8);
#define PG8_SA(b, h) (((b) * 2 + (h)) * HTB)
#define PG8_SB(b, h) ((4 + (b) * 2 + (h)) * HTB)
#define PG8_STAGE(bufoff, gbase, voff) do { _Pragma("unroll") for (int _i = 0; _i < 2; ++_i) \
        __builtin_amdgcn_global_load_lds((const unsigned*)((const char*)(gbase) + (voff)[_i]), (LAS unsigned*)(lds + (bufoff) + ldsw + _i * 8192), 16, 0, 0); } while (0)
#define PG8_LDA(dst, b, h) do { _Pragma("unroll") for (int m = 0; m < 4; ++m) _Pragma("unroll") for (int k = 0; k < 2; ++k) dst[m][k] = *(const LAS bf16x8*)(lds + PG8_SA(b, h) + aoff + m * 2048 + k * 1024); } while (0)
#define PG8_LDB(dst, b, h) do { _Pragma("unroll") for (int n = 0; n < 2; ++n) _Pragma("unroll") for (int k = 0; k < 2; ++k) dst[n][k] = *(const LAS bf16x8*)(lds + PG8_SB(b, h) + boff + n * 2048 + k * 1024); } while (0)
#define PG8_MMA(ai, bj, At, Bt) do { __builtin_amdgcn_s_setprio(1); _Pragma("unroll") for (int m = 0; m < 4; ++m) _Pragma("unroll") for (int n = 0; n < 2; ++n) _Pragma("unroll") for (int k = 0; k < 2; ++k) \
        acc[ai][bj][m][n] = __builtin_amdgcn_mfma_f32_16x16x32_bf16(Bt[n][k], At[m][k], acc[ai][bj][m][n], 0, 0, 0); __builtin_amdgcn_s_setprio(0); } while (0)
#define PG8_WAIT_V(n) asm volatile("s_waitcnt vmcnt(" #n ")" ::: "memory")
#define PG8_WAIT_L(n) asm volatile("s_waitcnt lgkmcnt(" #n ")" ::: "memory")
#define PG8_BAR __builtin_amdgcn_s_barrier()
#define PG8_SCHED __builtin_amdgcn_sched_barrier(0)
    Unit cur, nxt; int ui = 0;
    if (!S.next(0, cur)) return;
    f32x4 acc[2][2][4][2];
#pragma unroll
    for (int a = 0; a < 2; ++a)
#pragma unroll
        for (int b = 0; b < 2; ++b)
#pragma unroll
            for (int m = 0; m < 4; ++m)
#pragma unroll
                for (int n = 0; n < 2; ++n) acc[a][b][m][n] = (f32x4){0.f, 0.f, 0.f, 0.f};
    bf16x8 At[4][2], B0[2][2], B1[2][2];
    const char* cA = cur.a; const char* cB = cur.b;
    PG8_STAGE(PG8_SB(0, 0), cB, voffB); PG8_STAGE(PG8_SB(0, 1), cB + hstepB, voffB); PG8_STAGE(PG8_SA(0, 0), cA, voffA); PG8_STAGE(PG8_SA(0, 1), PG8_AH(cA), voffA1);
    if (wr == 1) PG8_BAR;
    PG8_WAIT_V(2); PG8_BAR;
    PG8_STAGE(PG8_SB(1, 0), cB + kstep, voffB); PG8_STAGE(PG8_SA(1, 0), cA + kstep, voffA); PG8_STAGE(PG8_SB(1, 1), cB + hstepB + kstep, voffB);
    PG8_WAIT_V(6); PG8_BAR;
    for (;;) {
        const bool has_next = S.next(ui + 1, nxt);
        const char* nA = has_next ? nxt.a : cA; const char* nB = has_next ? nxt.b : cB;
        const int nt = cur.nt;
        for (int t = 0; t < nt; t += 2) {
            const bool last = (t == nt - 2);
            const char* a1 = cA + (size_t)(t + 1) * kstep;
            const char* a2 = last ? nA : cA + (size_t)(t + 2) * kstep; const char* b2 = last ? nB : cB + (size_t)(t + 2) * kstep;
            const char* a3 = a2 + kstep; const char* b3 = b2 + kstep;
            PG8_LDB(B0, 0, 0); PG8_LDB(B1, 0, 1); PG8_SCHED; PG8_LDA(At, 0, 0); PG8_STAGE(PG8_SA(1, 1), PG8_AH(a1), voffA1);
            PG8_WAIT_V(8); PG8_WAIT_L(0); PG8_BAR; PG8_MMA(0, 0, At, B0); PG8_MMA(0, 1, At, B1); PG8_BAR; PG8_SCHED;
            PG8_LDA(At, 0, 1); PG8_STAGE(PG8_SB(0, 0), b2, voffB); PG8_STAGE(PG8_SB(0, 1), b2 + hstepB, voffB); PG8_STAGE(PG8_SA(0, 0), a2, voffA);
            PG8_WAIT_V(8); PG8_WAIT_L(0); PG8_BAR; PG8_MMA(1, 0, At, B0); PG8_MMA(1, 1, At, B1); PG8_BAR; PG8_SCHED;
            PG8_LDB(B0, 1, 0); PG8_LDB(B1, 1, 1); PG8_SCHED; PG8_LDA(At, 1, 0); PG8_STAGE(PG8_SA(0, 1), PG8_AH(a2), voffA1);
            PG8_WAIT_V(8); PG8_WAIT_L(0); PG8_BAR; PG8_MMA(0, 0, At, B0); PG8_MMA(0, 1, At, B1); PG8_BAR; PG8_SCHED;
            PG8_LDA(At, 1, 1); PG8_STAGE(PG8_SB(1, 0), b3, voffB); PG8_STAGE(PG8_SB(1, 1), b3 + hstepB, voffB); PG8_STAGE(PG8_SA(1, 0), a3, voffA);
            PG8_WAIT_V(8); PG8_WAIT_L(0); PG8_BAR; PG8_MMA(1, 0, At, B0); PG8_MMA(1, 1, At, B1); PG8_BAR; PG8_SCHED;
        }
        if constexpr (ALIGN_EPI) { if (wr == 0) PG8_BAR; }
        if constexpr (!Epi::AFTER_DRAIN) E(acc, cur, wr, wc, fr, fq);
        if (!has_next) break;
        if (!Epi::keep_acc(cur)) {
#pragma unroll
        for (int a = 0; a < 2; ++a)
#pragma unroll
            for (int b = 0; b < 2; ++b)
#pragma unroll
                for (int m = 0; m < 4; ++m)
#pragma unroll
                    for (int n = 0; n < 2; ++n) acc[a][b][m][n] = (f32x4){0.f, 0.f, 0.f, 0.f};
        }
        cur = nxt; cA = nA; cB = nB; ++ui;
        if constexpr (ALIGN_EPI) { if (wr == 1) PG8_BAR; }
    }
    PG8_WAIT_V(0);
    if constexpr (!ALIGN_EPI) { if (wr == 0) PG8_BAR; }
    PG8_BAR;
    if constexpr (Epi::AFTER_DRAIN) E.fused(acc, cur, wr, wc, fr, fq, lds, wid, lane);
#undef PG8_AH
#undef PG8_SA
#undef PG8_SB
#undef PG8_STAGE
#undef PG8_LDA
#undef PG8_LDB
#undef PG8_MMA
#undef PG8_WAIT_V
#undef PG8_WAIT_L
#undef PG8_BAR
#undef PG8_SCHED
}

struct SchedPlain {
    const bf16_t* A; const bf16_t* Bt; int lda, ldb, nM, nN, nt, G, c;
    __device__ __forceinline__ bool next(int i, Unit& u) const {
        const long L = (long)i * G + c; if (L >= (long)nM * nN) return false;
        int pm, pn; order_map((int)L, nM, nN, pm, pn);
        u.a = (const char*)(A + (size_t)pm * BM * lda); u.b = (const char*)(Bt + (size_t)pn * BM * ldb); u.nt = nt; u.pm = pm; u.pn = pn; u.kind = 0; return true;
    }
};
struct SchedIn {
    const bf16_t* XN; const bf16_t* Win; int G, c;
    __device__ __forceinline__ bool next(int i, Unit& u) const {
        const long L = (long)i * G + c;
        if (L < 64 * 22) { int pm, pn; order_map((int)L, 64, 22, pm, pn); pn = pn < 4 ? pn : pn + 2;
            u.a = (const char*)(XN + (size_t)pm * BM * DM); u.b = (const char*)(Win + (size_t)pn * BM * DM); u.nt = 16; u.pm = pm; u.pn = pn; u.kind = 0; return true; }
        if (L < 64 * 22 + 128) { const int j = (int)L - 64 * 22, tn = j >> 1, dm = j & 1;
            u.a = (const char*)(Win + (size_t)(C_V + dm * BM) * DM); u.b = (const char*)(XN + (size_t)tn * BM * DM); u.nt = 16; u.pm = dm; u.pn = tn; u.kind = 1; return true; }
        return false;
    }
};
struct SchedBr {
    const bf16_t* Y; const bf16_t* Wbr; int G, c;
    __device__ __forceinline__ bool next(int i, Unit& u) const {
        const int T = c + (i / 3) * G, seg = i % 3; if (T >= 256) return false;
        int pm, pn; order_map(T, 64, 4, pm, pn);
        const int k0 = seg == 0 ? 0 : (seg == 1 ? 512 : 768);
        u.a = (const char*)(Y + (size_t)pm * BM * DM + k0); u.b = (const char*)(Wbr + (size_t)pn * BM * DM + k0); u.nt = seg == 0 ? 8 : 4; u.pm = pm; u.pn = pn; u.kind = seg; return true;
    }
};

__device__ __forceinline__ void store8(bf16_t* p, f32x4 v0, f32x4 v1) { u32x4 w; w.x = pk2(v0[0], v0[1]); w.y = pk2(v0[2], v0[3]); w.z = pk2(v1[0], v1[1]); w.w = pk2(v1[2], v1[3]); *(u32x4*)p = w; }

struct EpiPlain { static constexpr bool AFTER_DRAIN = false; bf16_t* O; int ldc; const float* rs; static __device__ __forceinline__ bool keep_acc(const Unit&) { return false; }
    __device__ __forceinline__ void operator()(const f32x4 (&acc)[2][2][4][2], const Unit& u, int wr, int wc, int fr, int fq) const {
        const int row0 = u.pm * BM + wr * 64 + fr, col0 = u.pn * BM + wc * 32 + 8 * fq;
        float scv[2][4];
#pragma unroll
        for (int ai = 0; ai < 2; ++ai)
#pragma unroll
            for (int m = 0; m < 4; ++m) scv[ai][m] = rs ? rs[row0 + ai * HALF + m * 16] : 1.f;
#pragma unroll
        for (int ai = 0; ai < 2; ++ai)
#pragma unroll
            for (int m = 0; m < 4; ++m) { const int row = row0 + ai * HALF + m * 16; bf16_t* rowp = O + (size_t)row * ldc + col0; const float sc = scv[ai][m];
#pragma unroll
                for (int bj = 0; bj < 2; ++bj) store8(rowp + bj * HALF, acc[ai][bj][m][0] * sc, acc[ai][bj][m][1] * sc); }
    }
};
struct EpiIn { static constexpr bool AFTER_DRAIN = false; bf16_t* H; bf16_t* Vt; const float* bgate; const float* rs; float* LF; const float* bfg; static __device__ __forceinline__ bool keep_acc(const Unit&) { return false; }
    __device__ __forceinline__ void operator()(const f32x4 (&acc)[2][2][4][2], const Unit& u, int wr, int wc, int fr, int fq) const {
        if (u.kind == 0 && u.pn == 23) {
            if (wc == 0 && fq == 0) {
                const f32x4 bf0 = *(const f32x4*)bfg, bf1 = *(const f32x4*)(bfg + 4);
                float scl[2][4];
#pragma unroll
                for (int ai = 0; ai < 2; ++ai)
#pragma unroll
                    for (int m = 0; m < 4; ++m) scl[ai][m] = rs[u.pm * BM + wr * 64 + fr + ai * HALF + m * 16];
#pragma unroll
                for (int ai = 0; ai < 2; ++ai)
#pragma unroll
                    for (int m = 0; m < 4; ++m) { const int row = u.pm * BM + wr * 64 + fr + ai * HALF + m * 16; const float sc = scl[ai][m]; const int b = row / SEQ, t = row % SEQ;
#pragma unroll
                        for (int e = 0; e < 4; ++e) { const float z0 = acc[ai][0][m][0][e] * sc + bf0[e], z1 = acc[ai][0][m][1][e] * sc + bf1[e];
                            LF[(size_t)(b * 8 + e) * SEQ + t] = fminf(z0, 0.f) - __logf(1.f + __expf(-fabsf(z0)));
                            LF[(size_t)(b * 8 + 4 + e) * SEQ + t] = fminf(z1, 0.f) - __logf(1.f + __expf(-fabsf(z1))); } } }
            return; }
        bf16_t* base; int ld, mode;
        if (u.kind == 1) { base = Vt; ld = M; mode = 4; }
        else { base = H; ld = HW; const int pn = u.pn; mode = pn < 2 ? 1 : ((pn == 9 || pn == 10) ? 2 : (pn >= 11 ? 3 : 0)); }
        const int row0 = u.pm * BM + wr * 64 + fr, col0 = u.pn * BM + wc * 32 + 8 * fq;
        f32x4 bv[2][2];
#pragma unroll
        for (int bj = 0; bj < 2; ++bj)
#pragma unroll
            for (int n = 0; n < 2; ++n) bv[bj][n] = (mode == 3) ? *(const f32x4*)(bgate + (col0 - C_GATE) + bj * HALF + 4 * n) : ((mode == 4) ? *(const f32x4*)(rs + col0 + bj * HALF + 4 * n) : (f32x4){0.f, 0.f, 0.f, 0.f});
        float scv[2][4];
#pragma unroll
        for (int ai = 0; ai < 2; ++ai)
#pragma unroll
            for (int m = 0; m < 4; ++m) scv[ai][m] = (mode == 4) ? 1.f : rs[row0 + ai * HALF + m * 16];
#pragma unroll
        for (int ai = 0; ai < 2; ++ai)
#pragma unroll
            for (int m = 0; m < 4; ++m) { const int row = row0 + ai * HALF + m * 16; bf16_t* rowp = base + (size_t)row * ld + col0;
                const float sc = (mode == 1) ? scv[ai][m] * QSCALE : scv[ai][m];
#pragma unroll
                for (int bj = 0; bj < 2; ++bj) { f32x4 v0 = acc[ai][bj][m][0] * sc, v1 = acc[ai][bj][m][1] * sc;
                    if (mode == 4) { v0 = v0 * bv[bj][0]; v1 = v1 * bv[bj][1]; }
                    else if (mode == 2) {
#pragma unroll
                        for (int e = 0; e < 4; ++e) { v0[e] = gelu_t(v0[e]); v1[e] = gelu_t(v1[e]); } }
                    else if (mode == 3) {
#pragma unroll
                        for (int e = 0; e < 4; ++e) { v0[e] = inv_sigmoid_f(v0[e] + bv[bj][0][e]); v1[e] = inv_sigmoid_f(v1[e] + bv[bj][1][e]); } }
                    store8(rowp + bj * HALF, v0, v1); } }
    }
};
struct EpiBr { static constexpr bool AFTER_DRAIN = false; const bf16_t* H; bf16_t* MG;
    static __device__ __forceinline__ bool keep_acc(const Unit& u) { return u.kind != 2; }
    __device__ __forceinline__ void operator()(f32x4 (&acc)[2][2][4][2], const Unit& u, int wr, int wc, int fr, int fq) const {
        const int seg = u.kind;
        const int row0 = u.pm * BM + wr * 64 + fr, col0 = u.pn * BM + wc * 32 + 8 * fq;
#pragma unroll
        for (int ai = 0; ai < 2; ++ai) {
            u32x4 ga[4][2], gb[4][2];
#pragma unroll
            for (int m = 0; m < 4; ++m)
#pragma unroll
                for (int bj = 0; bj < 2; ++bj) { const bf16_t* gp = H + (size_t)(row0 + ai * HALF + m * 16) * HW + C_GATE + seg * DM + col0 + bj * HALF;
                    ga[m][bj] = __builtin_nontemporal_load((const u32x4*)gp); gb[m][bj] = (seg < 2) ? __builtin_nontemporal_load((const u32x4*)(gp + DM)) : (u32x4){0u, 0u, 0u, 0u}; }
#pragma unroll
            for (int m = 0; m < 4; ++m)
#pragma unroll
                for (int bj = 0; bj < 2; ++bj) { float g[8]; unpack8(ga[m][bj], g);
#pragma unroll
                    for (int e = 0; e < 8; ++e) g[e] = __builtin_amdgcn_rcpf(g[e]);
                    if (seg < 2) { float h[8]; unpack8(gb[m][bj], h);
#pragma unroll
                        for (int e = 0; e < 8; ++e) g[e] *= h[e];
#pragma unroll
                        for (int e = 0; e < 4; ++e) { acc[ai][bj][m][0][e] *= g[e]; acc[ai][bj][m][1][e] *= g[4 + e]; } }
                    else { f32x4 v0, v1;
#pragma unroll
                        for (int e = 0; e < 4; ++e) { v0[e] = acc[ai][bj][m][0][e] * g[e]; v1[e] = acc[ai][bj][m][1][e] * g[4 + e]; }
                        store8(MG + (size_t)(row0 + ai * HALF + m * 16) * DM + col0 + bj * HALF, v0, v1); } }
        }
    }
};
__device__ __forceinline__ float dpp_shr1(float old, float src) { return __builtin_bit_cast(float, __builtin_amdgcn_update_dpp(__builtin_bit_cast(int, old), __builtin_bit_cast(int, src), 0x111, 0xf, 0xf, false)); }
struct EpiConv { static constexpr bool AFTER_DRAIN = false; bf16_t* ACT; bf16_t* HALO; const float* cw; const float* rs; LAS unsigned char* ex;
    static __device__ __forceinline__ bool keep_acc(const Unit&) { return false; }
    __device__ __forceinline__ void operator()(f32x4 (&acc)[2][2][4][2], const Unit& u, int wr, int wc, int fr, int fq) const {
        const int colA = u.pn * 128 + wc * 32 + 8 * fq;
        const int tok0 = u.pm * BM + 8 * (16 * wr + fr);
        f32x4 cwv[2][3];
#pragma unroll
        for (int n = 0; n < 2; ++n) { const float* wp = cw + colA + 4 * n; cwv[n][0] = *(const f32x4*)wp; cwv[n][1] = *(const f32x4*)(wp + DFF2); cwv[n][2] = *(const f32x4*)(wp + 2 * DFF2); }
        { const f32x4 s0 = *(const f32x4*)(rs + tok0), s1 = *(const f32x4*)(rs + tok0 + 4);
#pragma unroll
          for (int m = 0; m < 4; ++m)
#pragma unroll
            for (int bj = 0; bj < 2; ++bj)
#pragma unroll
                for (int n = 0; n < 2; ++n) { acc[0][bj][m][n] = acc[0][bj][m][n] * s0[m]; acc[1][bj][m][n] = acc[1][bj][m][n] * s1[m]; } }
        LAS float* exw = (LAS float*)ex + (wc * 4 + fq) * 32;
        if (wr == 0 && fr == 15) {
#pragma unroll
            for (int bj = 0; bj < 2; ++bj)
#pragma unroll
                for (int n = 0; n < 2; ++n) { *(LAS f32x4*)(exw + (bj * 2 + n) * 4) = acc[1][bj][2][n]; *(LAS f32x4*)(exw + 16 + (bj * 2 + n) * 4) = acc[1][bj][3][n]; } }
        asm volatile("s_waitcnt lgkmcnt(0)" ::: "memory"); __builtin_amdgcn_s_barrier(); asm volatile("" ::: "memory");
        if (fr == 0 && wr == 0) {
#pragma unroll
            for (int bj = 0; bj < 2; ++bj) { store8(HALO + ((size_t)u.pm * 4 + 0) * DFF2 + bj * DFF + colA, acc[0][bj][0][0], acc[0][bj][0][1]); store8(HALO + ((size_t)u.pm * 4 + 1) * DFF2 + bj * DFF + colA, acc[0][bj][1][0], acc[0][bj][1][1]); } }
        if (fr == 15 && wr == 1) {
#pragma unroll
            for (int bj = 0; bj < 2; ++bj) { store8(HALO + ((size_t)u.pm * 4 + 2) * DFF2 + bj * DFF + colA, acc[1][bj][2][0], acc[1][bj][2][1]); store8(HALO + ((size_t)u.pm * 4 + 3) * DFF2 + bj * DFF + colA, acc[1][bj][3][0], acc[1][bj][3][1]); } }
#pragma unroll
        for (int bj = 0; bj < 2; ++bj)
#pragma unroll
            for (int n = 0; n < 2; ++n) { f32x4 e6 = (f32x4){0.f, 0.f, 0.f, 0.f}, e7 = e6, h2, h1;
                if (wr == 1) { e6 = *(const LAS f32x4*)(exw + (bj * 2 + n) * 4); e7 = *(const LAS f32x4*)(exw + 16 + (bj * 2 + n) * 4); }
#pragma unroll
                for (int e = 0; e < 4; ++e) { h2[e] = dpp_shr1(e6[e], acc[1][bj][2][n][e]); h1[e] = dpp_shr1(e7[e], acc[1][bj][3][n][e]); }
                const float* wp = cw + DFF + colA + 4 * n;
                const f32x4 w0 = bj == 0 ? cwv[n][0] : *(const f32x4*)wp, w1 = bj == 0 ? cwv[n][1] : *(const f32x4*)(wp + DFF2), w2 = bj == 0 ? cwv[n][2] : *(const f32x4*)(wp + 2 * DFF2);
#define XJ(j) acc[(j) >> 2][bj][(j) & 3][n]
                XJ(7) = w2 * XJ(7) + w1 * XJ(6) + w0 * XJ(5); XJ(6) = w2 * XJ(6) + w1 * XJ(5) + w0 * XJ(4); XJ(5) = w2 * XJ(5) + w1 * XJ(4) + w0 * XJ(3);
                XJ(4) = w2 * XJ(4) + w1 * XJ(3) + w0 * XJ(2); XJ(3) = w2 * XJ(3) + w1 * XJ(2) + w0 * XJ(1); XJ(2) = w2 * XJ(2) + w1 * XJ(1) + w0 * XJ(0);
                XJ(1) = w2 * XJ(1) + w1 * XJ(0) + w0 * h1; XJ(0) = w2 * XJ(0) + w1 * h1 + w0 * h2;
#undef XJ
            }
#pragma unroll
        for (int ai = 0; ai < 2; ++ai)
#pragma unroll
            for (int m = 0; m < 4; ++m) { f32x4 v0, v1;
#pragma unroll
                for (int e = 0; e < 4; ++e) { v0[e] = gelu_t(acc[ai][0][m][0][e]) * acc[ai][1][m][0][e]; v1[e] = gelu_t(acc[ai][0][m][1][e]) * acc[ai][1][m][1][e]; }
                store8(ACT + (size_t)(tok0 + 4 * ai + m) * DFF + colA, v0, v1); }
    }
};
struct PanelSum { float* X; unsigned* cnt; };
__device__ __forceinline__ void panel_sum(const PanelSum& ps, float (&v)[8], const Unit& u, int wr, int wc, int fr, int fq, LAS unsigned char* lds, int wid, int lane) {
    LAS float* P = (LAS float*)lds; LAS float* S = (LAS float*)(lds + 4096);
#pragma unroll
    for (int sl = 0; sl < 8; ++sl) { v[sl] += __shfl_xor(v[sl], 16); v[sl] += __shfl_xor(v[sl], 32); }
    if (fq == 0) {
#pragma unroll
        for (int sl = 0; sl < 8; ++sl) P[(128 * (sl >> 2) + 64 * wr + 16 * (sl & 3) + fr) * 4 + wc] = v[sl]; }
    __syncthreads();
    const int tid = wid * 64 + lane;
    if (tid < 256) { const float s = (P[tid * 4 + 0] + P[tid * 4 + 1]) + (P[tid * 4 + 2] + P[tid * 4 + 3]);
        __hip_atomic_store(ps.X + ((size_t)u.pm * 256 + tid) * 4 + u.pn, s, __ATOMIC_RELAXED, __HIP_MEMORY_SCOPE_AGENT); }
    asm volatile("s_waitcnt vmcnt(0)" ::: "memory");
    if (tid < 256 && lane == 0) __hip_atomic_fetch_add(ps.cnt + 64 * u.pm, 1u, __ATOMIC_RELAXED, __HIP_MEMORY_SCOPE_AGENT);
    if (wid == 0) { unsigned sp = 0;
        while ((unsigned)__builtin_amdgcn_readfirstlane(__hip_atomic_load(ps.cnt + 64 * u.pm, __ATOMIC_RELAXED, __HIP_MEMORY_SCOPE_AGENT)) < 16u) { __builtin_amdgcn_s_sleep(2); if (++sp > (1u << 22)) break; }
        __builtin_amdgcn_fence(__ATOMIC_ACQUIRE, "agent"); }
    asm volatile("s_waitcnt vmcnt(0) lgkmcnt(0)" ::: "memory");
    __syncthreads();
    if (tid < 256) { const float* xp = ps.X + ((size_t)u.pm * 256 + tid) * 4; float t = 0.f;
#pragma unroll
        for (int k = 0; k < 4; ++k) t += __hip_atomic_load(xp + k, __ATOMIC_RELAXED, __HIP_MEMORY_SCOPE_AGENT);
        S[tid] = t; }
    __syncthreads();
#pragma unroll
    for (int sl = 0; sl < 8; ++sl) v[sl] = S[128 * (sl >> 2) + 64 * wr + 16 * (sl & 3) + fr];
}
template <bool X_F32, bool FINAL> struct EpiResNorm {
    static constexpr bool AFTER_DRAIN = true;
    static __device__ __forceinline__ bool keep_acc(const Unit&) { return false; }
    const float* x32; bf16_t* XB; const float* gpost; float* RS; float* out; PanelSum s1, s2;
    __device__ __forceinline__ void operator()(f32x4 (&)[2][2][4][2], const Unit&, int, int, int, int) const {}
    __device__ __forceinline__ void fused(f32x4 (&acc)[2][2][4][2], const Unit& u, int wr, int wc, int fr, int fq, LAS unsigned char* lds, int wid, int lane) const {
        const int row0 = u.pm * BM + wr * 64 + fr, col0 = u.pn * BM + wc * 32 + 8 * fq;
        float v[8];
#pragma unroll
        for (int sl = 0; sl < 8; ++sl) { const int ai = sl >> 2, m = sl & 3; float s = 0.f;
#pragma unroll
            for (int bj = 0; bj < 2; ++bj)
#pragma unroll
                for (int n = 0; n < 2; ++n) { const f32x4 a = acc[ai][bj][m][n]; s += (a[0] * a[0] + a[1] * a[1]) + (a[2] * a[2] + a[3] * a[3]); }
            v[sl] = s; }
        u32x4 xr[4][2]; f32x4 g[2][2];
#pragma unroll
        for (int bj = 0; bj < 2; ++bj)
#pragma unroll
            for (int n = 0; n < 2; ++n) g[bj][n] = *(const f32x4*)(gpost + col0 + bj * HALF + 4 * n);
        if (!X_F32) {
#pragma unroll
            for (int sl = 0; sl < 4; ++sl)
#pragma unroll
                for (int bj = 0; bj < 2; ++bj) xr[sl][bj] = __builtin_nontemporal_load((const u32x4*)(XB + (size_t)(row0 + sl * 16) * DM + col0 + bj * HALF)); }
        panel_sum(s1, v, u, wr, wc, fr, fq, lds, wid, lane);
#pragma unroll
        for (int sl = 0; sl < 8; ++sl) { const int ai = sl >> 2, m = sl & 3; const size_t row = (size_t)(row0 + ai * HALF + m * 16);
            const float ry = __builtin_amdgcn_rsqf(v[sl] * (1.f / DM) + 1e-6f);
#pragma unroll
            for (int bj = 0; bj < 2; ++bj) { f32x4 x0, x1;
                if (X_F32) { x0 = *(const f32x4*)(x32 + row * DM + col0 + bj * HALF); x1 = *(const f32x4*)(x32 + row * DM + col0 + bj * HALF + 4); }
                else { float xf[8]; unpack8(sl < 4 ? xr[sl & 3][bj] : __builtin_nontemporal_load((const u32x4*)(XB + row * DM + col0 + bj * HALF)), xf); x0 = (f32x4){xf[0], xf[1], xf[2], xf[3]}; x1 = (f32x4){xf[4], xf[5], xf[6], xf[7]}; }
                acc[ai][bj][m][0] = x0 + acc[ai][bj][m][0] * ry * g[bj][0]; acc[ai][bj][m][1] = x1 + acc[ai][bj][m][1] * ry * g[bj][1]; } }
        if (FINAL) {
#pragma unroll
            for (int sl = 0; sl < 8; ++sl) { const int ai = sl >> 2, m = sl & 3; float* op = out + (size_t)(row0 + ai * HALF + m * 16) * DM + col0;
#pragma unroll
                for (int bj = 0; bj < 2; ++bj) { *(f32x4*)(op + bj * HALF) = acc[ai][bj][m][0]; *(f32x4*)(op + bj * HALF + 4) = acc[ai][bj][m][1]; } }
            return; }
#pragma unroll
        for (int sl = 0; sl < 8; ++sl) { const int ai = sl >> 2, m = sl & 3; float s = 0.f;
#pragma unroll
            for (int bj = 0; bj < 2; ++bj)
#pragma unroll
                for (int n = 0; n < 2; ++n) { const f32x4 a = acc[ai][bj][m][n]; s += (a[0] * a[0] + a[1] * a[1]) + (a[2] * a[2] + a[3] * a[3]); }
            v[sl] = s; }
        panel_sum(s2, v, u, wr, wc, fr, fq, lds, wid, lane);
#pragma unroll
        for (int sl = 0; sl < 8; ++sl) { const int ai = sl >> 2, m = sl & 3; const size_t row = (size_t)(row0 + ai * HALF + m * 16);
            if (u.pn == 0 && wc == 0 && fq == 0) RS[row] = __builtin_amdgcn_rsqf(v[sl] * (1.f / DM) + 1e-6f);
#pragma unroll
            for (int bj = 0; bj < 2; ++bj) store8(XB + row * DM + col0 + bj * HALF, acc[ai][bj][m][0], acc[ai][bj][m][1]); }
    }
};
}

struct Params { const float* in[20]; float* out; unsigned char* ws; };
enum { I_X = 0, I_PRE_MIX_G, I_POST_MIX_G, I_PRE_FFN_G, I_POST_FFN_G, I_W_IN, I_B_FORGET, I_B_GATE, I_CONV_MIX_W, I_SGU_LN_G, I_SGU_LN_B, I_SGU_W, I_SGU_B,
       I_W_BR_ATT, I_W_BR_CONV, I_W_BR_SGU, I_W_OUT, I_W_FFN_UP, I_CONV_FFN_W, I_W_FFN_DOWN };

__device__ __forceinline__ void tr_item(const float* W, int ldw, int srccol0, int k0, const float* gk, bf16_t* WT, int ldt, int dstrow0, int dstk0, LAS float* scr, int lane) {
    f32x4 v[8];
#pragma unroll
    for (int i = 0; i < 8; ++i) { const int kk = (lane >> 3) + 8 * i; v[i] = __builtin_nontemporal_load((const f32x4*)(W + (size_t)(k0 + kk) * ldw + srccol0 + 4 * (lane & 7))); }
#pragma unroll
    for (int i = 0; i < 8; ++i) { const int kk = (lane >> 3) + 8 * i; const float g = gk ? gk[k0 + kk] : 1.f; LAS float* d = scr + kk * 33 + 4 * (lane & 7);
        d[0] = v[i][0] * g; d[1] = v[i][1] * g; d[2] = v[i][2] * g; d[3] = v[i][3] * g; }
    asm volatile("s_waitcnt lgkmcnt(0)" ::: "memory");
    const int c = lane & 7;
#pragma unroll
    for (int j = 0; j < 4; ++j) { const int n = (lane >> 3) + 8 * j; const LAS float* s = scr + (8 * c) * 33 + n;
        u32x4 o; o.x = pk2(s[0 * 33], s[1 * 33]); o.y = pk2(s[2 * 33], s[3 * 33]); o.z = pk2(s[4 * 33], s[5 * 33]); o.w = pk2(s[6 * 33], s[7 * 33]);
        __builtin_nontemporal_store(o, (u32x4*)(WT + (size_t)(dstrow0 + n) * ldt + dstk0 + 8 * c)); }
    asm volatile("s_waitcnt lgkmcnt(0)" ::: "memory");
}
template <int PARTS>
__device__ __forceinline__ void convert_weights(const Params& p, int l, LAS unsigned char* lds, int gw, int NGW, int lane, int wave) {
    unsigned char* ws = p.ws;
    LAS float* scr = (LAS float*)(lds + 32768 + wave * 8448);
    const size_t ffo = (l & 1) ? (WS_FFN2 - WS_WUP) : 0;
    bf16_t* Win = (bf16_t*)(ws + WS_WIN); bf16_t* Wbr = (bf16_t*)(ws + WS_WBR); bf16_t* Wout = (bf16_t*)(ws + WS_WOUT); bf16_t* Wup = (bf16_t*)(ws + WS_WUP + ffo); bf16_t* Wdn = (bf16_t*)(ws + WS_WDN + ffo);
    constexpr int N_IN = 16 * 184, N_BA = 8 * 32, N_BC = 4 * 32, N_BS = 4 * 32, N_OUT = 16 * 32, N_UP = 16 * 176, N_DN = 44 * 32;
    if constexpr ((PARTS & 1) != 0) {
        const float* w_in = p.in[I_W_IN] + (size_t)l * DM * INW; const float* g1 = p.in[I_PRE_MIX_G] + l * DM;
        for (int r = gw; r < N_IN; r += NGW) { const int kb = r / 184, nb = r % 184, n0 = nb * 32; tr_item(w_in, INW, n0 + (n0 >= 1536 ? 8 : 0), kb * 64, g1, Win, DM, n0, kb * 64, scr, lane); }
        for (int e = gw * 64 + lane; e < 256 * DM / 2; e += NGW * 64) { const int idx = 2 * e, hrow = idx >> 10, k = idx & 1023;
            float a = 0.f, b = 0.f; if (hrow < 8) { a = g1[k] * w_in[(size_t)k * INW + 1536 + hrow]; b = g1[k + 1] * w_in[(size_t)(k + 1) * INW + 1536 + hrow]; }
            *(unsigned*)(Win + (size_t)5888 * DM + idx) = pk2(a, b); }
    }
    if constexpr ((PARTS & 2) != 0) {
        const float* w_out = p.in[I_W_OUT] + (size_t)l * DM * DM;
        const float* w_ba = p.in[I_W_BR_ATT] + (size_t)l * 512 * DM; const float* w_bc = p.in[I_W_BR_CONV] + (size_t)l * 256 * DM; const float* w_bs = p.in[I_W_BR_SGU] + (size_t)l * 256 * DM;
        for (int it = gw; it < N_BA + N_BC + N_BS + N_OUT; it += NGW) { int r = it;
            if (r < N_BA) { const int kb = r / 32, nb = r % 32; tr_item(w_ba, DM, nb * 32, kb * 64, nullptr, Wbr, DM, nb * 32, kb * 64, scr, lane); continue; } r -= N_BA;
            if (r < N_BC) { const int kb = r / 32, nb = r % 32; tr_item(w_bc, DM, nb * 32, kb * 64, nullptr, Wbr, DM, nb * 32, 512 + kb * 64, scr, lane); continue; } r -= N_BC;
            if (r < N_BS) { const int kb = r / 32, nb = r % 32; tr_item(w_bs, DM, nb * 32, kb * 64, nullptr, Wbr, DM, nb * 32, 768 + kb * 64, scr, lane); continue; } r -= N_BS;
            { const int kb = r / 32, nb = r % 32; tr_item(w_out, DM, nb * 32, kb * 64, nullptr, Wout, DM, nb * 32, kb * 64, scr, lane); } }
    }
    if constexpr ((PARTS & 4) != 0) {
        const float* w_up = p.in[I_W_FFN_UP] + (size_t)l * DM * DFF2; const float* w_dn = p.in[I_W_FFN_DOWN] + (size_t)l * DFF * DM; const float* g3 = p.in[I_PRE_FFN_G] + l * DM;
        for (int it = gw; it < N_UP + N_DN; it += NGW) { int r = it;
            if (r < N_UP) { const int kb = r / 176, nb = r % 176, n0 = nb * 32, nh = n0 < DFF ? n0 : n0 - DFF; const int drow = (nh >> 7) * 256 + (n0 < DFF ? 0 : 128) + (nh & 127);
                tr_item(w_up, DFF2, n0, kb * 64, g3, Wup, DM, drow, kb * 64, scr, lane); continue; } r -= N_UP;
            { const int kb = r / 32, nb = r % 32; tr_item(w_dn, DM, nb * 32, kb * 64, nullptr, Wdn, DFF, nb * 32, kb * 64, scr, lane); } }
        const float* sw = p.in[I_SGU_W] + (size_t)l * 4 * 128 * 128; bf16_t* Wm = (bf16_t*)(ws + WS_WM + ffo);
        for (int e = gw * 64 + lane; e < 4 * 128 * 128 / 2; e += NGW * 64) { const int idx = 2 * e, t = (idx >> 7) & 127, s = idx & 127;
            const float a = s <= t ? sw[idx] : 0.f, b = (s + 1) <= t ? sw[idx + 1] : 0.f; *(unsigned*)(Wm + idx) = pk2(a, b); }
    }
}

template <bool X_F32, bool HAS_Y, bool WR_XB, bool WR_LF, bool WR_OUT, int R = 4>
__device__ __forceinline__ void row_phase(const float* x32, const bf16_t* y, const float* gpost, bf16_t* XB, float* RS, float* out, LAS const float* wfl, const float* bfg, float* LF, int gw, int NGW, int lane) {
    for (int row0 = gw; row0 < M; row0 += R * NGW) {
        f32x4 v[R][4]; f32x4 yy[R][4]; bool ok[R]; float r[R];
#pragma unroll
        for (int u = 0; u < R; ++u) { const int row = row0 + u * NGW; ok[u] = row < M; const int rr = ok[u] ? row : row0;
#pragma unroll
            for (int j = 0; j < 4; ++j) {
                if (X_F32) v[u][j] = __builtin_nontemporal_load((const f32x4*)(x32 + (size_t)rr * DM + 256 * j + 4 * lane));
                else { const u32x2 w = *(const u32x2*)(XB + (size_t)rr * DM + 256 * j + 4 * lane); v[u][j] = (f32x4){bflo(w.x), bfhi(w.x), bflo(w.y), bfhi(w.y)}; } }
            if (HAS_Y) {
#pragma unroll
                for (int j = 0; j < 4; ++j) { const u32x2 w = *(const u32x2*)(y + (size_t)rr * DM + 256 * j + 4 * lane); yy[u][j] = (f32x4){bflo(w.x), bfhi(w.x), bflo(w.y), bfhi(w.y)}; } } }
        if (HAS_Y) {
#pragma unroll
            for (int u = 0; u < R; ++u) { const int row = row0 + u * NGW; float ss = 0.f;
#pragma unroll
                for (int j = 0; j < 4; ++j) ss += (yy[u][j][0] * yy[u][j][0] + yy[u][j][1] * yy[u][j][1]) + (yy[u][j][2] * yy[u][j][2] + yy[u][j][3] * yy[u][j][3]);
                ss = wave_sum(ss); const float ry = __builtin_amdgcn_rsqf(ss * (1.f / DM) + 1e-6f);
#pragma unroll
                for (int j = 0; j < 4; ++j) { const f32x4 g = *(const f32x4*)(gpost + 256 * j + 4 * lane); v[u][j] = v[u][j] + yy[u][j] * ry * g;
                    if (WR_OUT && ok[u]) *(f32x4*)(out + (size_t)row * DM + 256 * j + 4 * lane) = v[u][j]; } }
        }
        if (WR_XB) {
#pragma unroll
            for (int u = 0; u < R; ++u) { const int row = row0 + u * NGW; float s2 = 0.f;
#pragma unroll
                for (int j = 0; j < 4; ++j) s2 += (v[u][j][0] * v[u][j][0] + v[u][j][1] * v[u][j][1]) + (v[u][j][2] * v[u][j][2] + v[u][j][3] * v[u][j][3]);
                s2 = wave_sum(s2); r[u] = __builtin_amdgcn_rsqf(s2 * (1.f / DM) + 1e-6f);
                if (ok[u]) { if (lane == 0) RS[row] = r[u];
#pragma unroll
                    for (int j = 0; j < 4; ++j) { u32x2 w; w.x = pk2(v[u][j][0], v[u][j][1]); w.y = pk2(v[u][j][2], v[u][j][3]); *(u32x2*)(XB + (size_t)row * DM + 256 * j + 4 * lane) = w; } } }
            if (WR_LF) {
                float mine[R];
#pragma unroll
                for (int u = 0; u < R; ++u) mine[u] = 0.f;
#pragma unroll
                for (int h = 0; h < 8; ++h) { float pa[R];
#pragma unroll
                    for (int u = 0; u < R; ++u) pa[u] = 0.f;
#pragma unroll
                    for (int j = 0; j < 4; ++j) { const f32x4 w = *(const LAS f32x4*)(wfl + h * DM + 256 * j + 4 * lane);
#pragma unroll
                        for (int u = 0; u < R; ++u) pa[u] += (v[u][j][0] * w[0] + v[u][j][1] * w[1]) + (v[u][j][2] * w[2] + v[u][j][3] * w[3]); }
#pragma unroll
                    for (int u = 0; u < R; ++u) { pa[u] = wave_sum(pa[u]); if (lane == h) mine[u] = pa[u]; } }
#pragma unroll
                for (int u = 0; u < R; ++u) { const int row = row0 + u * NGW;
                    if (lane < 8 && ok[u]) { const float z = mine[u] * r[u] + bfg[lane]; const float lf = fminf(z, 0.f) - __logf(1.f + __expf(-fabsf(z)));
                        const int b = row / SEQ, t = row % SEQ; LF[(size_t)(b * 8 + lane) * SEQ + t] = lf; } }
            }
        }
    }
}
template <bool TO_LDS> __device__ __forceinline__ void build_wf(const Params& p, int l, LAS float* wfl, float* wfg) {
    const float* w_in = p.in[I_W_IN] + (size_t)l * DM * INW; const float* g1 = p.in[I_PRE_MIX_G] + l * DM;
    const int t0 = ltid(); float vals[16];
#pragma unroll
    for (int i = 0; i < 16; ++i) { const int idx = t0 + 512 * i, k = idx >> 3, h = idx & 7; vals[i] = g1[k] * w_in[(size_t)k * INW + 1536 + h]; }
#pragma unroll
    for (int i = 0; i < 16; ++i) { const int idx = t0 + 512 * i, k = idx >> 3, h = idx & 7; if (TO_LDS) wfl[h * DM + k] = vals[i]; else wfg[h * DM + k] = vals[i]; }
    __syncthreads();
}
__device__ __forceinline__ void load_wf(const float* wfg, LAS float* wfl) {
    const int t0 = ltid();
#pragma unroll
    for (int i = 0; i < 4; ++i) *(LAS f32x4*)(wfl + 4 * (t0 + 512 * i)) = *(const f32x4*)(wfg + 4 * (t0 + 512 * i));
    __syncthreads();
}

__device__ __forceinline__ float max3f(float a, float b, float c) { float r; asm("v_max3_f32 %0, %1, %2, %3" : "=v"(r) : "v"(a), "v"(b), "v"(c)); return r; }
constexpr int A_K = 0, A_KBUF = 64 * 144, A_V = 2 * A_KBUF, A_VBUF = 64 * 136, A_CS = 36864, A_WS = A_CS + 16384, A_KX = A_WS + 256;
__device__ __forceinline__ void attn_unit(LAS unsigned char* lds, const bf16_t* __restrict__ H, const bf16_t* __restrict__ Vt, const float* __restrict__ LF, bf16_t* __restrict__ Y, int b, int h, int qb, bool do_scan) {
    const int tid = ltid(), lane = tid & 63, wid = __builtin_amdgcn_readfirstlane(tid >> 6), r32 = lane & 31, hi = lane >> 5;
    const int q0 = qb * 256, NT = (q0 + 256) / 64;
    LAS float* cs = (LAS float*)(lds + A_CS); LAS float* wsum = (LAS float*)(lds + A_WS);
    const size_t rowbase = (size_t)b * SEQ;
    const bf16_t* kg = H + (rowbase + (tid >> 3)) * HW + C_K + h * 64 + (tid & 7) * 8;
    const bf16_t* vg = Vt + (size_t)(h * 64 + (tid >> 3)) * M + rowbase + (tid & 7) * 8;
    const int kw = (tid >> 3) * 144 + (tid & 7) * 16, vw = (tid >> 3) * 136 + (tid & 7) * 16;
    u32x4 kreg = *(const u32x4*)kg, vreg = *(const u32x4*)vg;
    u32x4 kreg2 = *(const u32x4*)(kg + (size_t)64 * HW), vreg2 = *(const u32x4*)(vg + 64);
    const int qpos = q0 + wid * 32 + r32;
    const bf16_t* qg = H + (rowbase + qpos) * HW + C_Q + h * 64 + hi * 8;
    bf16x8 qr[4];
#pragma unroll
    for (int ds = 0; ds < 4; ++ds) qr[ds] = *(const bf16x8*)(qg + ds * 16);
    if (do_scan) {
        const float* lf = LF + (size_t)(b * 8 + h) * SEQ + tid * 8;
        const f32x4 a0 = *(const f32x4*)lf, a1 = *(const f32x4*)(lf + 4);
        float v[8] = {a0[0], a0[1], a0[2], a0[3], a1[0], a1[1], a1[2], a1[3]};
#pragma unroll
        for (int j = 1; j < 8; ++j) v[j] += v[j - 1];
        const float tot = v[7]; float s = tot;
#pragma unroll
        for (int o = 1; o < 64; o <<= 1) { const float t = __shfl_up(s, o); if (lane >= o) s += t; }
        if (lane == 63) wsum[wid] = s;
        __syncthreads();
        float off = s - tot;
        for (int w = 0; w < wid; ++w) off += wsum[w];
        f32x4 c0, c1;
#pragma unroll
        for (int j = 0; j < 4; ++j) { c0[j] = (off + v[j]) * LOG2E; c1[j] = (off + v[4 + j]) * LOG2E; }
        *(LAS f32x4*)(cs + tid * 8) = c0; *(LAS f32x4*)(cs + tid * 8 + 4) = c1;
    }
    *(LAS u32x4*)(lds + A_K + kw) = kreg;
    *(LAS u32x2*)(lds + A_V + vw) = (u32x2){vreg.x, vreg.y}; *(LAS u32x2*)(lds + A_V + vw + 8) = (u32x2){vreg.z, vreg.w};
    __syncthreads();
    const float cref = cs[q0 + 255];
    const float cqr = cs[qpos] - cref;
    const unsigned ONES = hi ? 0u : 0x3F803F80u;
    LAS unsigned* kxw = (LAS unsigned*)(lds + A_KX);
    if (tid * 8 < NT * 64) { const f32x4 ca = *(const LAS f32x4*)(cs + tid * 8), cb = *(const LAS f32x4*)(cs + tid * 8 + 4); unsigned wv[8];
#pragma unroll
        for (int j = 0; j < 8; ++j) { const float b_ = (j < 4 ? ca[j & 3] : cb[j & 3]) - cref; const unsigned h_ = pk2(b_, 0.f) & 0xffffu; const float l_ = b_ - bflo(h_); wv[j] = (h_ | (pk2(l_, 0.f) << 16)) ^ 0x80008000u; }
        *(LAS u32x4*)(kxw + tid * 8) = (u32x4){wv[0], wv[1], wv[2], wv[3]}; *(LAS u32x4*)(kxw + tid * 8 + 4) = (u32x4){wv[4], wv[5], wv[6], wv[7]}; }
    __syncthreads();
    bf16x8 qx;
#define ATT_QX() do { const float a_ = cqr - mrun; const unsigned h_ = pk2(a_, 0.f) & 0xffffu; const float l_ = a_ - bflo(h_); \
        const unsigned w_ = hi ? 0u : (h_ | (pk2(l_, 0.f) << 16)); qx = __builtin_bit_cast(bf16x8, (u32x4){w_, ONES, 0u, 0u}); } while (0)
    f32x16 o0, o1;
#pragma unroll
    for (int r = 0; r < 16; ++r) { o0[r] = 0.f; o1[r] = 0.f; }
    float mrun = 0.f, lrun = 0.f;
    ATT_QX();
    const int wlim = (32 * wid + 31) >> 6;
    for (int t = 0; t < NT; ++t) {
        const int buf = t & 1;
        kreg = kreg2; vreg = vreg2;
        if (t + 2 < NT) { kreg2 = *(const u32x4*)(kg + (size_t)(t + 2) * 64 * HW); vreg2 = *(const u32x4*)(vg + (t + 2) * 64); }
        const int jb = t - (NT - 4);
        if (jb <= wlim) {
        const LAS unsigned char* kb = lds + A_K + buf * A_KBUF + r32 * 144 + hi * 16;
        const LAS unsigned char* vb = lds + A_V + buf * A_VBUF + r32 * 136 + hi * 8;
        bf16x8 kf0[4], kf1[4];
#pragma unroll
        for (int ds = 0; ds < 4; ++ds) { kf0[ds] = *(const LAS bf16x8*)(kb + ds * 32); kf1[ds] = *(const LAS bf16x8*)(kb + 32 * 144 + ds * 32); }
        f32x16 p0, p1;
#pragma unroll
        for (int r = 0; r < 16; ++r) { p0[r] = 0.f; p1[r] = 0.f; }
        bf16x8 kx0, kx1;
        { const unsigned w0 = hi ? 0u : kxw[t * 64 + r32], w1 = hi ? 0u : kxw[t * 64 + 32 + r32];
          kx0 = __builtin_bit_cast(bf16x8, (u32x4){ONES, w0, 0u, 0u}); kx1 = __builtin_bit_cast(bf16x8, (u32x4){ONES, w1, 0u, 0u}); }
        u32x2 vl0[4], vh0[4], vl1[4], vh1[4];
#pragma unroll
        for (int j = 0; j < 4; ++j) { vl0[j] = *(const LAS u32x2*)(vb + j * 32); vh0[j] = *(const LAS u32x2*)(vb + j * 32 + 16);
            vl1[j] = *(const LAS u32x2*)(vb + 32 * 136 + j * 32); vh1[j] = *(const LAS u32x2*)(vb + 32 * 136 + j * 32 + 16); }
        __builtin_amdgcn_s_setprio(1);
        p0 = __builtin_amdgcn_mfma_f32_32x32x16_bf16(kx0, qx, p0, 0, 0, 0); p1 = __builtin_amdgcn_mfma_f32_32x32x16_bf16(kx1, qx, p1, 0, 0, 0);
#pragma unroll
        for (int ds = 0; ds < 4; ++ds) { p0 = __builtin_amdgcn_mfma_f32_32x32x16_bf16(kf0[ds], qr[ds], p0, 0, 0, 0); p1 = __builtin_amdgcn_mfma_f32_32x32x16_bf16(kf1[ds], qr[ds], p1, 0, 0, 0); }
        __builtin_amdgcn_s_setprio(0);
        if (jb >= 0) { const int thr = qpos - (t * 64 + 4 * hi);
#pragma unroll
            for (int rg = 0; rg < 4; ++rg)
#pragma unroll
                for (int i = 0; i < 4; ++i) { if (8 * rg + i > thr) p0[4 * rg + i] = -INFINITY; if (8 * rg + i + 32 > thr) p1[4 * rg + i] = -INFINITY; } }
        float rm = fmaxf(p1[14], p1[15]);
#pragma unroll
        for (int r = 0; r < 14; ++r) rm = max3f(rm, p0[r], p1[r]);
        rm = max3f(rm, p0[14], p0[15]);
        { auto rr = __builtin_amdgcn_permlane32_swap(__builtin_bit_cast(unsigned, rm), __builtin_bit_cast(unsigned, rm), false, false);
          rm = fmaxf(__builtin_bit_cast(float, rr[0]), __builtin_bit_cast(float, rr[1])); }
        if (__any(rm > 8.f)) { const float dl = fmaxf(rm, 0.f); mrun += dl; const float f = __builtin_amdgcn_exp2f(-dl); lrun *= f;
#pragma unroll
            for (int r = 0; r < 16; ++r) { p0[r] -= dl; p1[r] -= dl; o0[r] *= f; o1[r] *= f; }
            ATT_QX(); }
        float ps0 = 0.f, ps1 = 0.f;
#pragma unroll
        for (int r = 0; r < 16; ++r) { p0[r] = __builtin_amdgcn_exp2f(p0[r]); p1[r] = __builtin_amdgcn_exp2f(p1[r]); ps0 += p0[r]; ps1 += p1[r]; }
        lrun += ps0 + ps1;
        bf16x8 pa[4];
        { u32x4 w;
          w.x = pk2(p0[0], p0[1]); w.y = pk2(p0[2], p0[3]); w.z = pk2(p0[4], p0[5]); w.w = pk2(p0[6], p0[7]); pa[0] = __builtin_bit_cast(bf16x8, w);
          w.x = pk2(p0[8], p0[9]); w.y = pk2(p0[10], p0[11]); w.z = pk2(p0[12], p0[13]); w.w = pk2(p0[14], p0[15]); pa[1] = __builtin_bit_cast(bf16x8, w);
          w.x = pk2(p1[0], p1[1]); w.y = pk2(p1[2], p1[3]); w.z = pk2(p1[4], p1[5]); w.w = pk2(p1[6], p1[7]); pa[2] = __builtin_bit_cast(bf16x8, w);
          w.x = pk2(p1[8], p1[9]); w.y = pk2(p1[10], p1[11]); w.z = pk2(p1[12], p1[13]); w.w = pk2(p1[14], p1[15]); pa[3] = __builtin_bit_cast(bf16x8, w); }
#pragma unroll
        for (int j = 0; j < 4; ++j) {
            const bf16x8 vf0 = __builtin_bit_cast(bf16x8, (u32x4){vl0[j].x, vl0[j].y, vh0[j].x, vh0[j].y}), vf1 = __builtin_bit_cast(bf16x8, (u32x4){vl1[j].x, vl1[j].y, vh1[j].x, vh1[j].y});
            o0 = __builtin_amdgcn_mfma_f32_32x32x16_bf16(vf0, pa[j], o0, 0, 0, 0); o1 = __builtin_amdgcn_mfma_f32_32x32x16_bf16(vf1, pa[j], o1, 0, 0, 0); }
        }
        if (t + 1 < NT) { const int nb = buf ^ 1;
            *(LAS u32x4*)(lds + A_K + nb * A_KBUF + kw) = kreg;
            *(LAS u32x2*)(lds + A_V + nb * A_VBUF + vw) = (u32x2){vreg.x, vreg.y}; *(LAS u32x2*)(lds + A_V + nb * A_VBUF + vw + 8) = (u32x2){vreg.z, vreg.w}; }
        __syncthreads();
    }
#undef ATT_QX
    lrun += __shfl_xor(lrun, 32);
    const float inv = 1.f / lrun;
    bf16_t* yp = Y + (rowbase + qpos) * DM + h * 64 + 4 * hi;
#pragma unroll
    for (int rg = 0; rg < 4; ++rg) {
        u32x2 w0, w1; w0.x = pk2(o0[4 * rg] * inv, o0[4 * rg + 1] * inv); w0.y = pk2(o0[4 * rg + 2] * inv, o0[4 * rg + 3] * inv);
        w1.x = pk2(o1[4 * rg] * inv, o1[4 * rg + 1] * inv); w1.y = pk2(o1[4 * rg + 2] * inv, o1[4 * rg + 3] * inv);
        *(u32x2*)(yp + 8 * rg) = w0; *(u32x2*)(yp + 32 + 8 * rg) = w1; }
}

__device__ __forceinline__ void sgu_unit(LAS unsigned char* lds, const Params& p, int l, const bf16_t* __restrict__ H, const bf16_t* __restrict__ Wm, bf16_t* __restrict__ Y, int unit) {
    const int tid = ltid(), lane = tid & 63, wid = __builtin_amdgcn_readfirstlane(tid >> 6), r32 = lane & 31, hi = lane >> 5;
    const size_t rowbase = (size_t)unit * 128;
    const float* lng = p.in[I_SGU_LN_G] + l * 256; const float* lnb = p.in[I_SGU_LN_B] + l * 256; const float* sb = p.in[I_SGU_B] + l * 512;
    LAS bf16_t* VT = (LAS bf16_t*)lds;
    const f32x4 g4 = *(const f32x4*)(lng + 4 * lane), b4 = *(const f32x4*)(lnb + 4 * lane);
    {
        u32x2 w[16];
#pragma unroll
        for (int i = 0; i < 16; ++i) w[i] = *(const u32x2*)(H + (rowbase + wid * 16 + i) * HW + C_VS + 4 * lane);
        f32x4 v[16]; float mu[16], var[16];
#pragma unroll
        for (int i = 0; i < 16; ++i) { v[i] = (f32x4){bflo(w[i].x), bfhi(w[i].x), bflo(w[i].y), bfhi(w[i].y)}; mu[i] = (v[i][0] + v[i][1]) + (v[i][2] + v[i][3]); }
#pragma unroll
        for (int i = 0; i < 16; ++i) mu[i] = wave_sum(mu[i]) * (1.f / 256.f);
#pragma unroll
        for (int i = 0; i < 16; ++i) { v[i] = v[i] - mu[i]; var[i] = (v[i][0] * v[i][0] + v[i][1] * v[i][1]) + (v[i][2] * v[i][2] + v[i][3] * v[i][3]); }
#pragma unroll
        for (int i = 0; i < 16; ++i) var[i] = wave_sum(var[i]) * (1.f / 256.f);
#pragma unroll
        for (int i = 0; i < 16; ++i) { const float rs = __builtin_amdgcn_rsqf(var[i] + 1e-5f); v[i] = v[i] * rs * g4 + b4; }
#pragma unroll
        for (int e = 0; e < 4; ++e) { u32x4 w0, w1;
            w0.x = pk2(v[0][e], v[1][e]); w0.y = pk2(v[2][e], v[3][e]); w0.z = pk2(v[4][e], v[5][e]); w0.w = pk2(v[6][e], v[7][e]);
            w1.x = pk2(v[8][e], v[9][e]); w1.y = pk2(v[10][e], v[11][e]); w1.z = pk2(v[12][e], v[13][e]); w1.w = pk2(v[14][e], v[15][e]);
            LAS u32x4* dst = (LAS u32x4*)(VT + (4 * lane + e) * 136 + wid * 16); dst[0] = w0; dst[1] = w1; }
    }
    __syncthreads();
    const int g = wid >> 1, db = wid & 1;
    const LAS unsigned char* ab = lds + ((g * 64 + db * 32 + r32) * 136 + hi * 8) * 2;
    bf16x8 bfr[4][8]; u32x2 uw[4][4]; float bsv[4];
#pragma unroll
    for (int tb = 0; tb < 4; ++tb) { const int t = tb * 32 + r32; const bf16_t* wrow = Wm + ((size_t)g * 128 + t) * 128 + hi * 8;
#pragma unroll
        for (int ks = 0; ks < 8; ++ks) if (ks < 2 * tb + 2) bfr[tb][ks] = *(const bf16x8*)(wrow + ks * 16);
        bsv[tb] = sb[g * 128 + t];
#pragma unroll
        for (int rg = 0; rg < 4; ++rg) uw[tb][rg] = *(const u32x2*)(H + (rowbase + t) * HW + C_U + g * 64 + db * 32 + 8 * rg + 4 * hi); }
#pragma unroll
    for (int tb = 0; tb < 4; ++tb) {
        f32x16 acc;
#pragma unroll
        for (int r = 0; r < 16; ++r) acc[r] = 0.f;
        const int t = tb * 32 + r32;
#pragma unroll
        for (int ks = 0; ks < 8; ++ks) if (ks < 2 * tb + 2) { const bf16x8 a = *(const LAS bf16x8*)(ab + ks * 32); acc = __builtin_amdgcn_mfma_f32_32x32x16_bf16(a, bfr[tb][ks], acc, 0, 0, 0); }
        const float bs = bsv[tb];
#pragma unroll
        for (int rg = 0; rg < 4; ++rg) { const int d4 = g * 64 + db * 32 + 8 * rg + 4 * hi; const u32x2 u2 = uw[tb][rg];
            u32x2 ow; ow.x = pk2(bflo(u2.x) * (acc[4 * rg] + bs), bfhi(u2.x) * (acc[4 * rg + 1] + bs)); ow.y = pk2(bflo(u2.y) * (acc[4 * rg + 2] + bs), bfhi(u2.y) * (acc[4 * rg + 3] + bs));
            *(u32x2*)(Y + (rowbase + t) * DM + 768 + d4) = ow; }
    }
    __syncthreads();
}

__device__ __forceinline__ void shortconv_items(const Params& p, int l, const bf16_t* __restrict__ H, bf16_t* __restrict__ Y, int gtid, int NTHR) {
    const float* cw = p.in[I_CONV_MIX_W] + l * 3 * 256;
#pragma unroll 2
    for (int it = gtid; it < (M / 2) * 32; it += NTHR) {
        const int cgp = it & 31, rp = it >> 5, t0 = 2 * rp, c0 = cgp * 8;
        float w0[8], w1[8], w2[8];
        { const f32x4 a0 = *(const f32x4*)(cw + c0), a1 = *(const f32x4*)(cw + c0 + 4), b0 = *(const f32x4*)(cw + 256 + c0), b1 = *(const f32x4*)(cw + 256 + c0 + 4), d0 = *(const f32x4*)(cw + 512 + c0), d1 = *(const f32x4*)(cw + 512 + c0 + 4);
#pragma unroll
          for (int e = 0; e < 4; ++e) { w0[e] = a0[e]; w0[4 + e] = a1[e]; w1[e] = b0[e]; w1[4 + e] = b1[e]; w2[e] = d0[e]; w2[4 + e] = d1[e]; } }
        float z[4][8];
        const bool head = (t0 % SEQ) == 0;
#pragma unroll
        for (int r = 0; r < 4; ++r) { const int tr = t0 - 2 + r;
            if (r < 2 && head) {
#pragma unroll
                for (int e = 0; e < 8; ++e) z[r][e] = 0.f; }
            else { float a[8], b[8]; unpack8(*(const u32x4*)(H + (size_t)tr * HW + C_CG + c0), a); unpack8(*(const u32x4*)(H + (size_t)tr * HW + C_HC + c0), b);
#pragma unroll
                for (int e = 0; e < 8; ++e) z[r][e] = a[e] * b[e]; } }
#pragma unroll
        for (int r = 0; r < 2; ++r) { float bg[8]; unpack8(*(const u32x4*)(H + (size_t)(t0 + r) * HW + C_BG + c0), bg); float o[8];
#pragma unroll
            for (int e = 0; e < 8; ++e) o[e] = bg[e] * (w0[e] * z[r][e] + w1[e] * z[r + 1][e] + w2[e] * z[r + 2][e]);
            pg8::store8(Y + (size_t)(t0 + r) * DM + 512 + c0, (f32x4){o[0], o[1], o[2], o[3]}, (f32x4){o[4], o[5], o[6], o[7]}); }
    }
}

__device__ __forceinline__ void convact_items(const Params& p, int l, const bf16_t* __restrict__ H2, bf16_t* __restrict__ ACT, int gtid, int NTHR) {
    const float* cw = p.in[I_CONV_FFN_W] + (size_t)l * 3 * DFF2;
    constexpr int NCG = DFF / 8;
    for (int it = gtid; it < (M / 8) * NCG; it += NTHR) {
        const int cgp = it % NCG, rgp = it / NCG, t0 = rgp * 8, c0 = cgp * 8;
        float wa[3][8], wb[3][8];
#pragma unroll
        for (int k = 0; k < 3; ++k)
#pragma unroll
            for (int e = 0; e < 8; ++e) { wa[k][e] = cw[k * DFF2 + c0 + e]; wb[k][e] = cw[k * DFF2 + DFF + c0 + e]; }
        float a0[8], a1[8], b0[8], b1[8];
        if ((t0 % SEQ) == 0) {
#pragma unroll
            for (int e = 0; e < 8; ++e) { a0[e] = 0.f; a1[e] = 0.f; b0[e] = 0.f; b1[e] = 0.f; } }
        else { unpack8(*(const u32x4*)(H2 + (size_t)(t0 - 2) * DFF2 + c0), a0); unpack8(*(const u32x4*)(H2 + (size_t)(t0 - 1) * DFF2 + c0), a1);
               unpack8(*(const u32x4*)(H2 + (size_t)(t0 - 2) * DFF2 + DFF + c0), b0); unpack8(*(const u32x4*)(H2 + (size_t)(t0 - 1) * DFF2 + DFF + c0), b1); }
#pragma unroll
        for (int r = 0; r < 8; ++r) { float a2[8], b2[8];
            unpack8(*(const u32x4*)(H2 + (size_t)(t0 + r) * DFF2 + c0), a2); unpack8(*(const u32x4*)(H2 + (size_t)(t0 + r) * DFF2 + DFF + c0), b2);
            float o[8];
#pragma unroll
            for (int e = 0; e < 8; ++e) { const float ca = wa[0][e] * a0[e] + wa[1][e] * a1[e] + wa[2][e] * a2[e]; const float cb = wb[0][e] * b0[e] + wb[1][e] * b1[e] + wb[2][e] * b2[e];
                o[e] = gelu_t(ca) * cb; a0[e] = a1[e]; a1[e] = a2[e]; b0[e] = b1[e]; b1[e] = b2[e]; }
            pg8::store8(ACT + (size_t)(t0 + r) * DFF + c0, (f32x4){o[0], o[1], o[2], o[3]}, (f32x4){o[4], o[5], o[6], o[7]}); }
    }
}


__device__ __forceinline__ void conv_fixup(const Params& p, int l, const bf16_t* HALO, bf16_t* ACT, int pm) {
    if ((pm & 15) == 0) return;
    const int t = ltid(); const float* cw = p.in[I_CONV_FFN_W] + (size_t)l * 3 * DFF2;
    if (t < DFF / 8) { const int c0 = t * 8;
        float o0[8], o1[8], av[2][8], bv[2][8];
#pragma unroll
        for (int half = 0; half < 2; ++half) { const int cc = half * DFF + c0;
            float r0[8], r1[8], p254[8], p255[8];
            unpack8(*(const u32x4*)(HALO + ((size_t)pm * 4 + 0) * DFF2 + cc), r0); unpack8(*(const u32x4*)(HALO + ((size_t)pm * 4 + 1) * DFF2 + cc), r1);
            unpack8(*(const u32x4*)(HALO + ((size_t)(pm - 1) * 4 + 2) * DFF2 + cc), p254); unpack8(*(const u32x4*)(HALO + ((size_t)(pm - 1) * 4 + 3) * DFF2 + cc), p255);
#pragma unroll
            for (int e = 0; e < 8; ++e) { const float w0 = cw[cc + e], w1 = cw[DFF2 + cc + e], w2 = cw[2 * DFF2 + cc + e];
                const float c_0 = w2 * r0[e] + w1 * p255[e] + w0 * p254[e], c_1 = w2 * r1[e] + w1 * r0[e] + w0 * p255[e];
                if (half == 0) { av[0][e] = c_0; av[1][e] = c_1; } else { bv[0][e] = c_0; bv[1][e] = c_1; } } }
#pragma unroll
        for (int e = 0; e < 8; ++e) { o0[e] = gelu_t(av[0][e]) * bv[0][e]; o1[e] = gelu_t(av[1][e]) * bv[1][e]; }
        pg8::store8(ACT + (size_t)(pm * 256) * DFF + c0, (f32x4){o0[0], o0[1], o0[2], o0[3]}, (f32x4){o0[4], o0[5], o0[6], o0[7]});
        pg8::store8(ACT + (size_t)(pm * 256 + 1) * DFF + c0, (f32x4){o1[0], o1[1], o1[2], o1[3]}, (f32x4){o1[4], o1[5], o1[6], o1[7]}); }
    asm volatile("s_waitcnt vmcnt(0)" ::: "memory");
    __syncthreads();
}

#define XB_TMO      128
#define XB_XCNT(j)  (256  + 64 * (j))
#define XB_XSUB(j)  (1280 + 64 * (j))
#define XB_XGEN(j)  (2304 + 64 * (j))
#define XB_TOP      3328
#define XB_TOPGEN   3392
#define XCD_BAR_WORDS 3456
#define XB_SPIN_CAP (1u << 22)
__device__ __forceinline__ unsigned xb_ld(unsigned* p)              { return __hip_atomic_load(p, __ATOMIC_RELAXED, __HIP_MEMORY_SCOPE_AGENT); }
__device__ __forceinline__ unsigned xb_add(unsigned* p, unsigned v) { return __hip_atomic_fetch_add(p, v, __ATOMIC_RELAXED, __HIP_MEMORY_SCOPE_AGENT); }
__device__ __forceinline__ unsigned xb_xcc_id() { return (unsigned)__builtin_amdgcn_s_getreg((3 << 11) | 20) & 0xFu; }
#define XB_SPIN(cond, bar) do { unsigned _sp = 0; while (cond) { __builtin_amdgcn_s_sleep(1); \
    if ((++_sp & 255u) == 0u) { if (xb_ld(&(bar)[XB_TMO])) break; if (_sp > XB_SPIN_CAP) { atomicAdd(&(bar)[XB_TMO], 1u); break; } } } } while (0)
struct XcdBarrier { unsigned* bar; unsigned x; volatile LAS unsigned* st; };
__device__ __forceinline__ XcdBarrier xcd_barrier_post(unsigned* bar, volatile LAS unsigned* st) {
    XcdBarrier b; b.bar = bar; b.x = xb_xcc_id(); b.st = st;
    if (threadIdx.x == 0) (void)xb_add(&bar[XB_XCNT(b.x)], 1u);
    return b;
}
__device__ __forceinline__ void xcd_barrier_complete(unsigned* bar, unsigned x, unsigned& nloc, unsigned& nx) {
    const unsigned G = gridDim.x * gridDim.y * gridDim.z;
    unsigned sum, cnt, mine, sp = 0u;
    for (;;) {
        sum = 0u; cnt = 0u; mine = 0u;
#pragma unroll
        for (unsigned j = 0; j < 16; ++j) { const unsigned c = xb_ld(&bar[XB_XCNT(j)]); sum += c; cnt += (c > 0u) ? 1u : 0u; mine = (j == x) ? c : mine; }
        if (sum == G) break;
        __builtin_amdgcn_s_sleep(1);
        if ((++sp & 255u) == 0u) { if (xb_ld(&bar[XB_TMO])) break; if (sp > XB_SPIN_CAP) { atomicAdd(&bar[XB_TMO], 1u); break; } }
    }
    nloc = mine > 0u ? mine : 1u; nx = cnt > 0u ? cnt : 1u;
}
__device__ __forceinline__ void xcd_barrier(const XcdBarrier& b) {
    asm volatile("s_waitcnt vmcnt(0)" ::: "memory");
    __syncthreads();
    if (threadIdx.x == 0) {
        unsigned* bar = b.bar;
        __builtin_amdgcn_s_waitcnt(0);
        unsigned nloc = b.st[0], nx = b.st[1];
        if (nloc == 0u) { xcd_barrier_complete(bar, b.x, nloc, nx); b.st[0] = nloc; b.st[1] = nx; }
        const unsigned old = xb_add(&bar[XB_XSUB(b.x)], 1u);
        const unsigned gen = old / nloc;
        if (old + 1u == (gen + 1u) * nloc) {
            __builtin_amdgcn_fence(__ATOMIC_RELEASE, "agent");
            asm volatile("s_waitcnt vmcnt(0)" ::: "memory");
            const unsigned og = xb_add(&bar[XB_TOP], 1u);
            const unsigned tg = og / nx;
            if (og + 1u == (tg + 1u) * nx) xb_add(&bar[XB_TOPGEN], 1u);
            else XB_SPIN(xb_ld(&bar[XB_TOPGEN]) == tg, bar);
            __builtin_amdgcn_fence(__ATOMIC_ACQUIRE, "agent");
            xb_add(&bar[XB_XGEN(b.x)], 1u);
            asm volatile("s_waitcnt vmcnt(0)" ::: "memory");
        } else {
            XB_SPIN(xb_ld(&bar[XB_XGEN(b.x)]) == gen, bar);
            __builtin_amdgcn_fence(__ATOMIC_ACQUIRE, "agent");
            asm volatile("s_waitcnt vmcnt(0)" ::: "memory");
        }
    }
    __syncthreads();
}
constexpr int EX_OFF = 131072 + 1024;
constexpr int MISC_OFF = 131072 + 512;
constexpr size_t WS_BAR = 65536;

__global__ void __launch_bounds__(512, 2) fwd_megakernel(Params p_unused) {
    extern __shared__ __attribute__((aligned(16))) unsigned char lds_raw[];
    cg::grid_group grid = cg::this_grid();
    LAS unsigned char* lds = (LAS unsigned char*)lds_raw;
    LAS float* wfl = (LAS float*)lds;
    (void)p_unused;
    if (threadIdx.x < 64) ((LAS unsigned*)(lds + MISC_OFF))[threadIdx.x] = 0u;
    __syncthreads();
    { auto kz = __builtin_amdgcn_kernarg_segment_ptr(); unsigned char* wz = ((const Params*)kz)->ws; const int gz = blockIdx.x * 512 + threadIdx.x;
      if (gz < (384 - 64) * 1024 / 16) ((u32x4*)(wz + 65536))[gz] = (u32x4){0u, 0u, 0u, 0u}; }
    grid.sync();
    { auto ka0 = __builtin_amdgcn_kernarg_segment_ptr(); const Params& p0 = *(const Params*)ka0; (void)xcd_barrier_post((unsigned*)(p0.ws + WS_BAR), (volatile LAS unsigned*)(lds + MISC_OFF)); }
#define GRID_BAR() do { auto kb_ = __builtin_amdgcn_kernarg_segment_ptr(); asm volatile("" : "+s"(kb_)); XcdBarrier b_; b_.bar = (unsigned*)(((const Params*)kb_)->ws + WS_BAR); b_.x = xb_xcc_id(); \
        b_.st = (volatile LAS unsigned*)(lds + MISC_OFF); xcd_barrier(b_); } while (0)
#define PHASE_BEGIN \
    auto ka_ = __builtin_amdgcn_kernarg_segment_ptr(); asm volatile("" : "+s"(ka_)); \
    const Params& p = *(const Params*)ka_; \
    int l = l_loop; asm volatile("" : "+s"(l)); \
    const int tid = ltid(), lane = tid & 63, wave = __builtin_amdgcn_readfirstlane(tid >> 6); \
    int G = gridDim.x, bx = blockIdx.x; asm volatile("" : "+s"(G), "+s"(bx)); \
    const int gw = bx * 8 + wave, NGW = G * 8, gtid = bx * 512 + tid, NTHR = G * 512; \
    unsigned char* ws = p.ws; float* LF = (float*)(ws + WS_LF); float* RS = (float*)(ws + WS_RS); (void)RS; \
    bf16_t* Win = (bf16_t*)(ws + WS_WIN); bf16_t* Wbr = (bf16_t*)(ws + WS_WBR); bf16_t* Wout = (bf16_t*)(ws + WS_WOUT); const size_t ffo = (l & 1) ? (WS_FFN2 - WS_WUP) : 0; bf16_t* Wup = (bf16_t*)(ws + WS_WUP + ffo); bf16_t* Wdn = (bf16_t*)(ws + WS_WDN + ffo); bf16_t* Wm = (bf16_t*)(ws + WS_WM + ffo); \
    bf16_t* XN = (bf16_t*)(ws + WS_XN); bf16_t* Y = (bf16_t*)(ws + WS_Y); bf16_t* MG = (bf16_t*)(ws + WS_MG); bf16_t* ACT = (bf16_t*)(ws + WS_ACT); \
    bf16_t* Vt = (bf16_t*)(ws + WS_VT); bf16_t* H = (bf16_t*)(ws + WS_H); bf16_t* H2 = H; bf16_t* YO = H; float* xres = p.out; \
    (void)l; (void)lane; (void)gw; (void)NGW; (void)gtid; (void)NTHR; (void)LF; (void)Win; (void)Wbr; (void)Wout; (void)Wup; (void)Wdn; (void)Wm; (void)XN; (void)Y; (void)MG; (void)ACT; (void)Vt; (void)H; (void)H2; (void)YO; (void)xres;

    { const int l_loop = 0; PHASE_BEGIN
      row_phase<true, false, true, false, false>(p.in[I_X], nullptr, nullptr, XN, RS, nullptr, nullptr, nullptr, nullptr, gw, NGW, lane);
      convert_weights<7>(p, 0, lds, gw, NGW, lane, wave); }
    GRID_BAR();

    for (int l_loop = 0; l_loop < DEPTH; ++l_loop) {
        { PHASE_BEGIN pg8::SchedIn S{XN, Win, G, bx}; pg8::EpiIn E{H, Vt, p.in[I_B_GATE] + l * 3 * DM, RS, LF, p.in[I_B_FORGET] + l * 8};
          pg8::gemm_phase<pg8::EpiIn, pg8::SchedIn, true>(lds, DM, DM, S, E); }
        GRID_BAR();
        { PHASE_BEGIN
          for (int u = bx; u < 256; u += G) { const int bh = (u & 7) * 4 + (u >> 6), s = (u >> 3) & 7;     attn_unit(lds, H, Vt, LF, Y, bh >> 3, bh & 7, s, true); attn_unit(lds, H, Vt, LF, Y, bh >> 3, bh & 7, 15 - s, false); }
          __syncthreads();
          for (int u = bx; u < 128; u += G) sgu_unit(lds, p, l, H, Wm, Y, u);
          shortconv_items(p, l, H, Y, gtid, NTHR);
 }
        GRID_BAR();
        { PHASE_BEGIN pg8::SchedBr S{Y, Wbr, G, bx}; pg8::EpiBr E{H, MG};
          pg8::gemm_phase<pg8::EpiBr, pg8::SchedBr, true>(lds, DM, DM, S, E); }
        GRID_BAR();
        { PHASE_BEGIN pg8::SchedPlain S{MG, Wout, DM, DM, 64, 4, 16, G, bx};
          unsigned* cb = (unsigned*)(ws + WS_CNT) + (size_t)(4 * l) * 4096;
          const pg8::PanelSum s1{(float*)(ws + WS_X1), cb}, s2{(float*)(ws + WS_X2), cb + 4096};
          { pg8::EpiResNorm<false, false> E{nullptr, XN, p.in[I_POST_MIX_G] + l * DM, RS, nullptr, s1, s2}; pg8::gemm_phase<pg8::EpiResNorm<false, false>, pg8::SchedPlain, false>(lds, DM, DM, S, E); } }
        GRID_BAR();
        { PHASE_BEGIN pg8::SchedPlain S{XN, Wup, DM, DM, 64, 22, 16, G, bx}; pg8::EpiConv E{ACT, (bf16_t*)(ws + WS_HALO), p.in[I_CONV_FFN_W] + (size_t)l * 3 * DFF2, RS, lds + EX_OFF};
          pg8::gemm_phase<pg8::EpiConv, pg8::SchedPlain, true, true>(lds, DM, DM, S, E);
          if (G == 256 && bx >= 128 && l + 1 < DEPTH) convert_weights<7>(p, l + 1, lds, (bx - 128) * 8 + wave, 128 * 8, lane, wave); }
        GRID_BAR();
        { PHASE_BEGIN pg8::SchedPlain S{ACT, Wdn, DFF, DFF, 64, 4, 44, G, bx};
          { pg8::Unit u0; if (S.next(0, u0)) conv_fixup(p, l, (const bf16_t*)(ws + WS_HALO), ACT, u0.pm); }
          unsigned* cb = (unsigned*)(ws + WS_CNT) + (size_t)(4 * l + 2) * 4096;
          const pg8::PanelSum s1{(float*)(ws + WS_X1), cb}, s2{(float*)(ws + WS_X2), cb + 4096};
          if (l + 1 < DEPTH) { pg8::EpiResNorm<false, false> E{nullptr, XN, p.in[I_POST_FFN_G] + l * DM, RS, nullptr, s1, s2}; pg8::gemm_phase<pg8::EpiResNorm<false, false>, pg8::SchedPlain, false>(lds, DFF, DFF, S, E); }
          else { pg8::EpiResNorm<false, true> E{nullptr, XN, p.in[I_POST_FFN_G] + l * DM, nullptr, xres, s1, s2}; pg8::gemm_phase<pg8::EpiResNorm<false, true>, pg8::SchedPlain, false>(lds, DFF, DFF, S, E); } }
        if (l_loop + 1 < DEPTH) {
            GRID_BAR();
            if (gridDim.x != 256) { { PHASE_BEGIN convert_weights<7>(p, l + 1, lds, gw, NGW, lane, wave); } GRID_BAR(); }
        }
    }
#undef PHASE_BEGIN
#undef GRID_BAR
}

extern "C" void kernel_launch(void* const* d_in, const int* in_sizes, int n_in, void* d_out, int out_size, void* d_ws, size_t ws_size, hipStream_t stream) {
    static int grid = 0;
    if (grid == 0) {
        if (n_in != 20 || out_size != M * DM || ws_size < WS_END) { fprintf(stderr, "kernel_launch: unexpected problem (n_in %d, out %d, ws %zu)\n", n_in, out_size, ws_size); grid = -1; return; }
        int dev = 0, cus = 0, per_cu = 0;
        hipGetDevice(&dev); hipDeviceGetAttribute(&cus, hipDeviceAttributeMultiprocessorCount, dev);
        if (hipFuncSetAttribute((const void*)fwd_megakernel, hipFuncAttributeMaxDynamicSharedMemorySize, LDS_BYTES) != hipSuccess) { fprintf(stderr, "kernel_launch: hipFuncSetAttribute failed\n"); grid = -1; return; }
        hipOccupancyMaxActiveBlocksPerMultiprocessor(&per_cu, (const void*)fwd_megakernel, 512, LDS_BYTES);
        if (per_cu < 1) { fprintf(stderr, "kernel_launch: occupancy query says %d blocks per CU\n", per_cu); per_cu = 1; }
        (void)hipGetLastError();
        grid = cus;
    }
    if (grid < 0) return;
    Params p{};
    for (int i = 0; i < 20; ++i) p.in[i] = (const float*)d_in[i];
    p.out = (float*)d_out; p.ws = (unsigned char*)d_ws;
    void* args[] = {&p};
    hipError_t e = hipLaunchCooperativeKernel((const void*)fwd_megakernel, dim3(grid), dim3(512), args, LDS_BYTES, stream);
    if (e != hipSuccess) fprintf(stderr, "cooperative launch failed: %s (grid %d)\n", hipGetErrorString(e), grid);
}
```

```cpp
#include <hip/hip_runtime.h>
#include <hip/hip_cooperative_groups.h>
#include <cstdio>
#include <cstdint>
namespace cg = cooperative_groups;

#define LAS __attribute__((address_space(3)))
typedef unsigned short bf16_t;
typedef short bf16x8 __attribute__((ext_vector_type(8)));
typedef float f32x4 __attribute__((ext_vector_type(4)));
typedef float f32x16 __attribute__((ext_vector_type(16)));
typedef unsigned u32x4 __attribute__((ext_vector_type(4)));
typedef unsigned u32x2 __attribute__((ext_vector_type(2)));
typedef float f32x2_t __attribute__((ext_vector_type(2)));
typedef __bf16 bf16x2_t __attribute__((ext_vector_type(2)));

constexpr int DM = 1024, SEQ = 4096, NB = 4, M = NB * SEQ, DEPTH = 4;
constexpr int INW = 5896;
constexpr int HW = 5888;
constexpr int DFF = 2816, DFF2 = 5632;
constexpr int C_Q = 0, C_K = 512, C_V = 1024, C_BG = 1536, C_CG = 1792, C_HC = 2048, C_U = 2304, C_VS = 2560, C_GATE = 2816;
constexpr float LOG2E = 1.4426950408889634f;
constexpr float QSCALE = 0.125f * LOG2E;

constexpr size_t MiB = 1u << 20;
constexpr size_t WS_LF = 1 * MiB;
constexpr size_t WS_RS = 1 * MiB + 512 * 1024;
constexpr size_t WS_CNT = 128 * 1024;
constexpr size_t WS_X1 = 512 * 1024, WS_X2 = 768 * 1024;
constexpr size_t WS_WFG = 1 * MiB + 768 * 1024;
constexpr size_t WS_WIN = 2 * MiB;
constexpr size_t WS_WBR = 14 * MiB;
constexpr size_t WS_WOUT = 16 * MiB;
constexpr size_t WS_WUP = 18 * MiB;
constexpr size_t WS_WDN = 29 * MiB;
constexpr size_t WS_WM = 35 * MiB;
constexpr size_t WS_XN = 36 * MiB;
constexpr size_t WS_Y = 68 * MiB;
constexpr size_t WS_MG = 100 * MiB;
constexpr size_t WS_ACT = 68 * MiB;
constexpr size_t WS_VT = 132 * MiB;
constexpr size_t WS_H = 156 * MiB;
constexpr size_t WS_HALO = 340 * MiB;
constexpr size_t WS_FFN2 = 344 * MiB;
constexpr size_t WS_FFN_BYTES = 35 * MiB + 128 * 1024 - 18 * MiB;
constexpr size_t WS_END = 362 * MiB;

constexpr int LDS_BYTES = 147456;

__device__ __forceinline__ unsigned pk2(float lo, float hi) { f32x2_t v = {lo, hi}; bf16x2_t b = __builtin_convertvector(v, bf16x2_t); return __builtin_bit_cast(unsigned, b); }
__device__ __forceinline__ float bflo(unsigned w) { return __builtin_bit_cast(float, w << 16); }
__device__ __forceinline__ float bfhi(unsigned w) { return __builtin_bit_cast(float, w & 0xffff0000u); }
__device__ __forceinline__ float gelu_t(float x) { const float u = x * (1.f + 0.044715f * x * x); const float e = __builtin_amdgcn_exp2f(-2.3022081981f * u); return x * __builtin_amdgcn_rcpf(1.f + e); }
__device__ __forceinline__ float inv_sigmoid_f(float z) { return fminf(1.f + __builtin_amdgcn_exp2f(-LOG2E * z), 1e6f); }
__device__ __forceinline__ float sigmoid_f(float z) { return __builtin_amdgcn_rcpf(1.f + __builtin_amdgcn_exp2f(-LOG2E * z)); }
__device__ __forceinline__ float wave_sum(float v) {
#pragma unroll
    for (int o = 1; o < 64; o <<= 1) v += __shfl_xor(v, o);
    return v;
}
__device__ __forceinline__ void unpack8(u32x4 w, float* f) { f[0] = bflo(w.x); f[1] = bfhi(w.x); f[2] = bflo(w.y); f[3] = bfhi(w.y); f[4] = bflo(w.z); f[5] = bfhi(w.z); f[6] = bflo(w.w); f[7] = bfhi(w.w); }

__device__ __forceinline__ int ltid() { int t = threadIdx.x; asm volatile("" : "+v"(t)); return t; }
template <class T> __device__ __forceinline__ T* launder(T* p) { asm volatile("" : "+s"(p)); return p; }

namespace pg8 {
constexpr int BM = 256, BK = 64, HALF = 128, HTB = HALF * BK * 2, STAGE_BYTES = 8 * HTB, NXCD = 8, WGM = 8;
__host__ __device__ __forceinline__ int lds_byte(int r, int c) { const int st = (r >> 4) * 2 + (c >> 5), rr = r & 15, cc = c & 31, ob = rr * 64 + cc * 2; return st * 1024 + (ob ^ (((ob >> 9) & 1) << 5)); }
__host__ __device__ __forceinline__ void stage_rc(int b, int& R, int& C) { const int st = b / 1024, sb = b % 1024, swz = sb ^ (((sb >> 9) & 1) << 5); R = (st >> 1) * 16 + swz / 64; C = (st & 1) * 32 + (swz % 64) / 2; }
__host__ __device__ __forceinline__ int perm32(int rho) { const int n = rho >> 4, i = rho & 15; return 8 * (i >> 2) + 4 * n + (i & 3); }

struct Unit { const char* a; const char* b; int nt, pm, pn, kind; };

__device__ __forceinline__ void order_map(int L, int nM, int nN, int& pm, int& pn) {
    const int nwg = nM * nN; int wgid = L;
    { const int q = nwg / NXCD, r = nwg % NXCD, xcd = wgid % NXCD, off = wgid / NXCD; wgid = (xcd < r ? xcd * (q + 1) : r * (q + 1) + (xcd - r) * q) + off; }
    const int nig = WGM * nN, gid = wgid / nig, fm = gid * WGM, gsz = (nM - fm) < WGM ? (nM - fm) : WGM;
    pm = fm + ((wgid % nig) % gsz); pn = (wgid % nig) / gsz;
}

template <class Epi, class Sched, bool ALIGN_EPI, bool APERM = false>
__device__ __forceinline__ void gemm_phase(LAS unsigned char* lds, const int lda, const int ldb, const Sched& S, const Epi& E) {
    const int tid = ltid(), wid = __builtin_amdgcn_readfirstlane(tid >> 6), lane = tid & 63, wr = wid >> 2, wc = wid & 3, fr = lane & 15, fq = lane >> 4;
    unsigned voffA[2], voffA1[2], voffB[2];
#pragma unroll
    for (int i = 0; i < 2; ++i) { int R, C; stage_rc(tid * 16 + i * 8192, R, C); const int Rb = (R & ~31) + perm32(R & 31);
        const int T0 = 8 * (16 * (R >> 6) + (R & 15)) + ((R >> 4) & 3);
        voffA[i] = (unsigned)((APERM ? T0 : R) * lda + C) * 2u; voffA1[i] = (unsigned)((APERM ? T0 + 4 : R) * lda + C) * 2u; voffB[i] = (unsigned)(Rb * ldb + C) * 2u; }
#define PG8_AH(ptr) (APERM ? (ptr) : (ptr) + hstepA)
    const size_t kstep = (size_t)(BK * 2);
    const size_t hstepA = (size_t)HALF * lda * 2, hstepB = (size_t)HALF * ldb * 2;
    const unsigned ldsw = (unsigned)wid * 1024u;
    const int aoff = lds_byte(wr * 64 + fr, fq * 8), boff = lds_byte(wc * 32 + fr, fq * 8);
#define PG8_SA(b, h) (((b) * 2 + (h)) * HTB)
#define PG8_SB(b, h) ((4 + (b) * 2 + (h)) * HTB)
#define PG8_STAGE(bufoff, gbase, voff) do { _Pragma("unroll") for (int _i = 0; _i < 2; ++_i) \
        __builtin_amdgcn_global_load_lds((const unsigned*)((const char*)(gbase) + (voff)[_i]), (LAS unsigned*)(lds + (bufoff) + ldsw + _i * 8192), 16, 0, 0); } while (0)
#define PG8_LDA(dst, b, h) do { _Pragma("unroll") for (int m = 0; m < 4; ++m) _Pragma("unroll") for (int k = 0; k < 2; ++k) dst[m][k] = *(const LAS bf16x8*)(lds + PG8_SA(b, h) + aoff + m * 2048 + k * 1024); } while (0)
#define PG8_LDB(dst, b, h) do { _Pragma("unroll") for (int n = 0; n < 2; ++n) _Pragma("unroll") for (int k = 0; k < 2; ++k) dst[n][k] = *(const LAS bf16x8*)(lds + PG8_SB(b, h) + boff + n * 2048 + k * 1024); } while (0)
#define PG8_MMA(ai, bj, At, Bt) do { __builtin_amdgcn_s_setprio(1); _Pragma("unroll") for (int m = 0; m < 4; ++m) _Pragma("unroll") for (int n = 0; n < 2; ++n) _Pragma("unroll") for (int k = 0; k < 2; ++k) \
        acc[ai][bj][m][n] = __builtin_amdgcn_mfma_f32_16x16x32_bf16(Bt[n][k], At[m][k], acc[ai][bj][m][n], 0, 0, 0); __builtin_amdgcn_s_setprio(0); } while (0)
#define PG8_WAIT_V(n) asm volatile("s_waitcnt vmcnt(" #n ")" ::: "memory")
#define PG8_WAIT_L(n) asm volatile("s_waitcnt lgkmcnt(" #n ")" ::: "memory")
#define PG8_BAR __builtin_amdgcn_s_barrier()
#define PG8_SCHED __builtin_amdgcn_sched_barrier(0)
    Unit cur, nxt; int ui = 0;
    if (!S.next(0, cur)) return;
    f32x4 acc[2][2][4][2];
#pragma unroll
    for (int a = 0; a < 2; ++a)
#pragma unroll
        for (int b = 0; b < 2; ++b)
#pragma unroll
            for (int m = 0; m < 4; ++m)
#pragma unroll
                for (int n = 0; n < 2; ++n) acc[a][b][m][n] = (f32x4){0.f, 0.f, 0.f, 0.f};
    bf16x8 At[4][2], B0[2][2], B1[2][2];
    const char* cA = cur.a; const char* cB = cur.b;
    PG8_STAGE(PG8_SB(0, 0), cB, voffB); PG8_STAGE(PG8_SB(0, 1), cB + hstepB, voffB); PG8_STAGE(PG8_SA(0, 0), cA, voffA); PG8_STAGE(PG8_SA(0, 1), PG8_AH(cA), voffA1);
    if (wr == 1) PG8_BAR;
    PG8_WAIT_V(2); PG8_BAR;
    PG8_STAGE(PG8_SB(1, 0), cB + kstep, voffB); PG8_STAGE(PG8_SA(1, 0), cA + kstep, voffA); PG8_STAGE(PG8_SB(1, 1), cB + hstepB + kstep, voffB);
    PG8_WAIT_V(6); PG8_BAR;
    for (;;) {
        const bool has_next = S.next(ui + 1, nxt);
        const char* nA = has_next ? nxt.a : cA; const char* nB = has_next ? nxt.b : cB;
        const int nt = cur.nt;
        for (int t = 0; t < nt; t += 2) {
            const bool last = (t == nt - 2);
            const char* a1 = cA + (size_t)(t + 1) * kstep;
            const char* a2 = last ? nA : cA + (size_t)(t + 2) * kstep; const char* b2 = last ? nB : cB + (size_t)(t + 2) * kstep;
            const char* a3 = a2 + kstep; const char* b3 = b2 + kstep;
            PG8_LDB(B0, 0, 0); PG8_LDB(B1, 0, 1); PG8_SCHED; PG8_LDA(At, 0, 0); PG8_STAGE(PG8_SA(1, 1), PG8_AH(a1), voffA1);
            PG8_WAIT_V(8); PG8_WAIT_L(0); PG8_BAR; PG8_MMA(0, 0, At, B0); PG8_MMA(0, 1, At, B1); PG8_BAR; PG8_SCHED;
            PG8_LDA(At, 0, 1); PG8_STAGE(PG8_SB(0, 0), b2, voffB); PG8_STAGE(PG8_SB(0, 1), b2 + hstepB, voffB); PG8_STAGE(PG8_SA(0, 0), a2, voffA);
            PG8_WAIT_V(8); PG8_WAIT_L(0); PG8_BAR; PG8_MMA(1, 0, At, B0); PG8_MMA(1, 1, At, B1); PG8_BAR; PG8_SCHED;
            PG8_LDB(B0, 1, 0); PG8_LDB(B1, 1, 1); PG8_SCHED; PG8_LDA(At, 1, 0); PG8_STAGE(PG8_SA(0, 1), PG8_AH(a2), voffA1);
            PG8_WAIT_V(8); PG8_WAIT_L(0); PG8_BAR; PG8_MMA(0, 0, At, B0); PG8_MMA(0, 1, At, B1); PG8_BAR; PG8_SCHED;
            PG8_LDA(At, 1, 1); PG8_STAGE(PG8_SB(1, 0), b3, voffB); PG8_STAGE(PG8_SB(1, 1), b3 + hstepB, voffB); PG8_STAGE(PG8_SA(1, 0), a3, voffA);
            PG8_WAIT_V(8); PG8_WAIT_L(0); PG8_BAR; PG8_MMA(1, 0, At, B0); PG8_MMA(1, 1, At, B1); PG8_BAR; PG8_SCHED;
        }
        if constexpr (ALIGN_EPI) { if (wr == 0) PG8_BAR; }
        if constexpr (!Epi::AFTER_DRAIN) E(acc, cur, wr, wc, fr, fq);
        if (!has_next) break;
        if (!Epi::keep_acc(cur)) {
#pragma unroll
        for (int a = 0; a < 2; ++a)
#pragma unroll
            for (int b = 0; b < 2; ++b)
#pragma unroll
                for (int m = 0; m < 4; ++m)
#pragma unroll
                    for (int n = 0; n < 2; ++n) acc[a][b][m][n] = (f32x4){0.f, 0.f, 0.f, 0.f};
        }
        cur = nxt; cA = nA; cB = nB; ++ui;
        if constexpr (ALIGN_EPI) { if (wr == 1) PG8_BAR; }
    }
    PG8_WAIT_V(0);
    if constexpr (!ALIGN_EPI) { if (wr == 0) PG8_BAR; }
    PG8_BAR;
    if constexpr (Epi::AFTER_DRAIN) E.fused(acc, cur, wr, wc, fr, fq, lds, wid, lane);
#undef PG8_AH
#undef PG8_SA
#undef PG8_SB
#undef PG8_STAGE
#undef PG8_LDA
#undef PG8_LDB
#undef PG8_MMA
#undef PG8_WAIT_V
#undef PG8_WAIT_L
#undef PG8_BAR
#undef PG8_SCHED
}

struct SchedPlain {
    const bf16_t* A; const bf16_t* Bt; int lda, ldb, nM, nN, nt, G, c;
    __device__ __forceinline__ bool next(int i, Unit& u) const {
        const long L = (long)i * G + c; if (L >= (long)nM * nN) return false;
        int pm, pn; order_map((int)L, nM, nN, pm, pn);
        u.a = (const char*)(A + (size_t)pm * BM * lda); u.b = (const char*)(Bt + (size_t)pn * BM * ldb); u.nt = nt; u.pm = pm; u.pn = pn; u.kind = 0; return true;
    }
};
struct SchedIn {
    const bf16_t* XN; const bf16_t* Win; int G, c;
    __device__ __forceinline__ bool next(int i, Unit& u) const {
        const long L = (long)i * G + c;
        if (L < 64 * 22) { int pm, pn; order_map((int)L, 64, 22, pm, pn); pn = pn < 4 ? pn : pn + 2;
            u.a = (const char*)(XN + (size_t)pm * BM * DM); u.b = (const char*)(Win + (size_t)pn * BM * DM); u.nt = 16; u.pm = pm; u.pn = pn; u.kind = 0; return true; }
        if (L < 64 * 22 + 128) { const int j = (int)L - 64 * 22, tn = j >> 1, dm = j & 1;
            u.a = (const char*)(Win + (size_t)(C_V + dm * BM) * DM); u.b = (const char*)(XN + (size_t)tn * BM * DM); u.nt = 16; u.pm = dm; u.pn = tn; u.kind = 1; return true; }
        return false;
    }
};
struct SchedBr {
    const bf16_t* Y; const bf16_t* Wbr; int G, c;
    __device__ __forceinline__ bool next(int i, Unit& u) const {
        const int T = c + (i / 3) * G, seg = i % 3; if (T >= 256) return false;
        int pm, pn; order_map(T, 64, 4, pm, pn);
        const int k0 = seg == 0 ? 0 : (seg == 1 ? 512 : 768);
        u.a = (const char*)(Y + (size_t)pm * BM * DM + k0); u.b = (const char*)(Wbr + (size_t)pn * BM * DM + k0); u.nt = seg == 0 ? 8 : 4; u.pm = pm; u.pn = pn; u.kind = seg; return true;
    }
};

__device__ __forceinline__ void store8(bf16_t* p, f32x4 v0, f32x4 v1) { u32x4 w; w.x = pk2(v0[0], v0[1]); w.y = pk2(v0[2], v0[3]); w.z = pk2(v1[0], v1[1]); w.w = pk2(v1[2], v1[3]); *(u32x4*)p = w; }

struct EpiPlain { static constexpr bool AFTER_DRAIN = false; bf16_t* O; int ldc; const float* rs; static __device__ __forceinline__ bool keep_acc(const Unit&) { return false; }
    __device__ __forceinline__ void operator()(const f32x4 (&acc)[2][2][4][2], const Unit& u, int wr, int wc, int fr, int fq) const {
        const int row0 = u.pm * BM + wr * 64 + fr, col0 = u.pn * BM + wc * 32 + 8 * fq;
        float scv[2][4];
#pragma unroll
        for (int ai = 0; ai < 2; ++ai)
#pragma unroll
            for (int m = 0; m < 4; ++m) scv[ai][m] = rs ? rs[row0 + ai * HALF + m * 16] : 1.f;
#pragma unroll
        for (int ai = 0; ai < 2; ++ai)
#pragma unroll
            for (int m = 0; m < 4; ++m) { const int row = row0 + ai * HALF + m * 16; bf16_t* rowp = O + (size_t)row * ldc + col0; const float sc = scv[ai][m];
#pragma unroll
                for (int bj = 0; bj < 2; ++bj) store8(rowp + bj * HALF, acc[ai][bj][m][0] * sc, acc[ai][bj][m][1] * sc); }
    }
};
struct EpiIn { static constexpr bool AFTER_DRAIN = false; bf16_t* H; bf16_t* Vt; const float* bgate; const float* rs; float* LF; const float* bfg; static __device__ __forceinline__ bool keep_acc(const Unit&) { return false; }
    __device__ __forceinline__ void operator()(const f32x4 (&acc)[2][2][4][2], const Unit& u, int wr, int wc, int fr, int fq) const {
        if (u.kind == 0 && u.pn == 23) {
            if (wc == 0 && fq == 0) {
                const f32x4 bf0 = *(const f32x4*)bfg, bf1 = *(const f32x4*)(bfg + 4);
                float scl[2][4];
#pragma unroll
                for (int ai = 0; ai < 2; ++ai)
#pragma unroll
                    for (int m = 0; m < 4; ++m) scl[ai][m] = rs[u.pm * BM + wr * 64 + fr + ai * HALF + m * 16];
#pragma unroll
                for (int ai = 0; ai < 2; ++ai)
#pragma unroll
                    for (int m = 0; m < 4; ++m) { const int row = u.pm * BM + wr * 64 + fr + ai * HALF + m * 16; const float sc = scl[ai][m]; const int b = row / SEQ, t = row % SEQ;
#pragma unroll
                        for (int e = 0; e < 4; ++e) { const float z0 = acc[ai][0][m][0][e] * sc + bf0[e], z1 = acc[ai][0][m][1][e] * sc + bf1[e];
                            LF[(size_t)(b * 8 + e) * SEQ + t] = fminf(z0, 0.f) - __logf(1.f + __expf(-fabsf(z0)));
                            LF[(size_t)(b * 8 + 4 + e) * SEQ + t] = fminf(z1, 0.f) - __logf(1.f + __expf(-fabsf(z1))); } } }
            return; }
        bf16_t* base; int ld, mode;
        if (u.kind == 1) { base = Vt; ld = M; mode = 4; }
        else { base = H; ld = HW; const int pn = u.pn; mode = pn < 2 ? 1 : ((pn == 9 || pn == 10) ? 2 : (pn >= 11 ? 3 : 0)); }
        const int row0 = u.pm * BM + wr * 64 + fr, col0 = u.pn * BM + wc * 32 + 8 * fq;
        f32x4 bv[2][2];
#pragma unroll
        for (int bj = 0; bj < 2; ++bj)
#pragma unroll
            for (int n = 0; n < 2; ++n) bv[bj][n] = (mode == 3) ? *(const f32x4*)(bgate + (col0 - C_GATE) + bj * HALF + 4 * n) : ((mode == 4) ? *(const f32x4*)(rs + col0 + bj * HALF + 4 * n) : (f32x4){0.f, 0.f, 0.f, 0.f});
        float scv[2][4];
#pragma unroll
        for (int ai = 0; ai < 2; ++ai)
#pragma unroll
            for (int m = 0; m < 4; ++m) scv[ai][m] = (mode == 4) ? 1.f : rs[row0 + ai * HALF + m * 16];
#pragma unroll
        for (int ai = 0; ai < 2; ++ai)
#pragma unroll
            for (int m = 0; m < 4; ++m) { const int row = row0 + ai * HALF + m * 16; bf16_t* rowp = base + (size_t)row * ld + col0;
                const float sc = (mode == 1) ? scv[ai][m] * QSCALE : scv[ai][m];
#pragma unroll
                for (int bj = 0; bj < 2; ++bj) { f32x4 v0 = acc[ai][bj][m][0] * sc, v1 = acc[ai][bj][m][1] * sc;
                    if (mode == 4) { v0 = v0 * bv[bj][0]; v1 = v1 * bv[bj][1]; }
                    else if (mode == 2) {
#pragma unroll
                        for (int e = 0; e < 4; ++e) { v0[e] = gelu_t(v0[e]); v1[e] = gelu_t(v1[e]); } }
                    else if (mode == 3) {
#pragma unroll
                        for (int e = 0; e < 4; ++e) { v0[e] = inv_sigmoid_f(v0[e] + bv[bj][0][e]); v1[e] = inv_sigmoid_f(v1[e] + bv[bj][1][e]); } }
                    store8(rowp + bj * HALF, v0, v1); } }
    }
};
struct EpiBr { static constexpr bool AFTER_DRAIN = false; const bf16_t* H; bf16_t* MG;
    static __device__ __forceinline__ bool keep_acc(const Unit& u) { return u.kind != 2; }
    __device__ __forceinline__ void operator()(f32x4 (&acc)[2][2][4][2], const Unit& u, int wr, int wc, int fr, int fq) const {
        const int seg = u.kind;
        const int row0 = u.pm * BM + wr * 64 + fr, col0 = u.pn * BM + wc * 32 + 8 * fq;
#pragma unroll
        for (int ai = 0; ai < 2; ++ai) {
            u32x4 ga[4][2], gb[4][2];
#pragma unroll
            for (int m = 0; m < 4; ++m)
#pragma unroll
                for (int bj = 0; bj < 2; ++bj) { const bf16_t* gp = H + (size_t)(row0 + ai * HALF + m * 16) * HW + C_GATE + seg * DM + col0 + bj * HALF;
                    ga[m][bj] = __builtin_nontemporal_load((const u32x4*)gp); gb[m][bj] = (seg < 2) ? __builtin_nontemporal_load((const u32x4*)(gp + DM)) : (u32x4){0u, 0u, 0u, 0u}; }
#pragma unroll
            for (int m = 0; m < 4; ++m)
#pragma unroll
                for (int bj = 0; bj < 2; ++bj) { float g[8]; unpack8(ga[m][bj], g);
#pragma unroll
                    for (int e = 0; e < 8; ++e) g[e] = __builtin_amdgcn_rcpf(g[e]);
                    if (seg < 2) { float h[8]; unpack8(gb[m][bj], h);
#pragma unroll
                        for (int e = 0; e < 8; ++e) g[e] *= h[e];
#pragma unroll
                        for (int e = 0; e < 4; ++e) { acc[ai][bj][m][0][e] *= g[e]; acc[ai][bj][m][1][e] *= g[4 + e]; } }
                    else { f32x4 v0, v1;
#pragma unroll
                        for (int e = 0; e < 4; ++e) { v0[e] = acc[ai][bj][m][0][e] * g[e]; v1[e] = acc[ai][bj][m][1][e] * g[4 + e]; }
                        store8(MG + (size_t)(row0 + ai * HALF + m * 16) * DM + col0 + bj * HALF, v0, v1); } }
        }
    }
};
__device__ __forceinline__ float dpp_shr1(float old, float src) { return __builtin_bit_cast(float, __builtin_amdgcn_update_dpp(__builtin_bit_cast(int, old), __builtin_bit_cast(int, src), 0x111, 0xf, 0xf, false)); }
struct EpiConv { static constexpr bool AFTER_DRAIN = false; bf16_t* ACT; bf16_t* HALO; const float* cw; const float* rs; LAS unsigned char* ex;
    static __device__ __forceinline__ bool keep_acc(const Unit&) { return false; }
    __device__ __forceinline__ void operator()(f32x4 (&acc)[2][2][4][2], const Unit& u, int wr, int wc, int fr, int fq) const {
        const int colA = u.pn * 128 + wc * 32 + 8 * fq;
        const int tok0 = u.pm * BM + 8 * (16 * wr + fr);
        f32x4 cwv[2][3];
#pragma unroll
        for (int n = 0; n < 2; ++n) { const float* wp = cw + colA + 4 * n; cwv[n][0] = *(const f32x4*)wp; cwv[n][1] = *(const f32x4*)(wp + DFF2); cwv[n][2] = *(const f32x4*)(wp + 2 * DFF2); }
        { const f32x4 s0 = *(const f32x4*)(rs + tok0), s1 = *(const f32x4*)(rs + tok0 + 4);
#pragma unroll
          for (int m = 0; m < 4; ++m)
#pragma unroll
            for (int bj = 0; bj < 2; ++bj)
#pragma unroll
                for (int n = 0; n < 2; ++n) { acc[0][bj][m][n] = acc[0][bj][m][n] * s0[m]; acc[1][bj][m][n] = acc[1][bj][m][n] * s1[m]; } }
        LAS float* exw = (LAS float*)ex + (wc * 4 + fq) * 32;
        if (wr == 0 && fr == 15) {
#pragma unroll
            for (int bj = 0; bj < 2; ++bj)
#pragma unroll
                for (int n = 0; n < 2; ++n) { *(LAS f32x4*)(exw + (bj * 2 + n) * 4) = acc[1][bj][2][n]; *(LAS f32x4*)(exw + 16 + (bj * 2 + n) * 4) = acc[1][bj][3][n]; } }
        asm volatile("s_waitcnt lgkmcnt(0)" ::: "memory"); __builtin_amdgcn_s_barrier(); asm volatile("" ::: "memory");
        if (fr == 0 && wr == 0) {
#pragma unroll
            for (int bj = 0; bj < 2; ++bj) { store8(HALO + ((size_t)u.pm * 4 + 0) * DFF2 + bj * DFF + colA, acc[0][bj][0][0], acc[0][bj][0][1]); store8(HALO + ((size_t)u.pm * 4 + 1) * DFF2 + bj * DFF + colA, acc[0][bj][1][0], acc[0][bj][1][1]); } }
        if (fr == 15 && wr == 1) {
#pragma unroll
            for (int bj = 0; bj < 2; ++bj) { store8(HALO + ((size_t)u.pm * 4 + 2) * DFF2 + bj * DFF + colA, acc[1][bj][2][0], acc[1][bj][2][1]); store8(HALO + ((size_t)u.pm * 4 + 3) * DFF2 + bj * DFF + colA, acc[1][bj][3][0], acc[1][bj][3][1]); } }
#pragma unroll
        for (int bj = 0; bj < 2; ++bj)
#pragma unroll
            for (int n = 0; n < 2; ++n) { f32x4 e6 = (f32x4){0.f, 0.f, 0.f, 0.f}, e7 = e6, h2, h1;
                if (wr == 1) { e6 = *(const LAS f32x4*)(exw + (bj * 2 + n) * 4); e7 = *(const LAS f32x4*)(exw + 16 + (bj * 2 + n) * 4); }
#pragma unroll
                for (int e = 0; e < 4; ++e) { h2[e] = dpp_shr1(e6[e], acc[1][bj][2][n][e]); h1[e] = dpp_shr1(e7[e], acc[1][bj][3][n][e]); }
                const float* wp = cw + DFF + colA + 4 * n;
                const f32x4 w0 = bj == 0 ? cwv[n][0] : *(const f32x4*)wp, w1 = bj == 0 ? cwv[n][1] : *(const f32x4*)(wp + DFF2), w2 = bj == 0 ? cwv[n][2] : *(const f32x4*)(wp + 2 * DFF2);
#define XJ(j) acc[(j) >> 2][bj][(j) & 3][n]
                XJ(7) = w2 * XJ(7) + w1 * XJ(6) + w0 * XJ(5); XJ(6) = w2 * XJ(6) + w1 * XJ(5) + w0 * XJ(4); XJ(5) = w2 * XJ(5) + w1 * XJ(4) + w0 * XJ(3);
                XJ(4) = w2 * XJ(4) + w1 * XJ(3) + w0 * XJ(2); XJ(3) = w2 * XJ(3) + w1 * XJ(2) + w0 * XJ(1); XJ(2) = w2 * XJ(2) + w1 * XJ(1) + w0 * XJ(0);
                XJ(1) = w2 * XJ(1) + w1 * XJ(0) + w0 * h1; XJ(0) = w2 * XJ(0) + w1 * h1 + w0 * h2;
#undef XJ
            }
#pragma unroll
        for (int ai = 0; ai < 2; ++ai)
#pragma unroll
            for (int m = 0; m < 4; ++m) { f32x4 v0, v1;
#pragma unroll
                for (int e = 0; e < 4; ++e) { v0[e] = gelu_t(acc[ai][0][m][0][e]) * acc[ai][1][m][0][e]; v1[e] = gelu_t(acc[ai][0][m][1][e]) * acc[ai][1][m][1][e]; }
                store8(ACT + (size_t)(tok0 + 4 * ai + m) * DFF + colA, v0, v1); }
    }
};
struct PanelSum { float* X; unsigned* cnt; };
__device__ __forceinline__ void panel_sum(const PanelSum& ps, float (&v)[8], const Unit& u, int wr, int wc, int fr, int fq, LAS unsigned char* lds, int wid, int lane) {
    LAS float* P = (LAS float*)lds; LAS float* S = (LAS float*)(lds + 4096);
#pragma unroll
    for (int sl = 0; sl < 8; ++sl) { v[sl] += __shfl_xor(v[sl], 16); v[sl] += __shfl_xor(v[sl], 32); }
    if (fq == 0) {
#pragma unroll
        for (int sl = 0; sl < 8; ++sl) P[(128 * (sl >> 2) + 64 * wr + 16 * (sl & 3) + fr) * 4 + wc] = v[sl]; }
    __syncthreads();
    const int tid = wid * 64 + lane;
    if (tid < 256) { const float s = (P[tid * 4 + 0] + P[tid * 4 + 1]) + (P[tid * 4 + 2] + P[tid * 4 + 3]);
        __hip_atomic_store(ps.X + ((size_t)u.pm * 256 + tid) * 4 + u.pn, s, __ATOMIC_RELAXED, __HIP_MEMORY_SCOPE_AGENT); }
    asm volatile("s_waitcnt vmcnt(0)" ::: "memory");
    if (tid < 256 && lane == 0) __hip_atomic_fetch_add(ps.cnt + 64 * u.pm, 1u, __ATOMIC_RELAXED, __HIP_MEMORY_SCOPE_AGENT);
    if (wid == 0) { unsigned sp = 0;
        while ((unsigned)__builtin_amdgcn_readfirstlane(__hip_atomic_load(ps.cnt + 64 * u.pm, __ATOMIC_RELAXED, __HIP_MEMORY_SCOPE_AGENT)) < 16u) { __builtin_amdgcn_s_sleep(2); if (++sp > (1u << 22)) break; }
        __builtin_amdgcn_fence(__ATOMIC_ACQUIRE, "agent"); }
    asm volatile("s_waitcnt vmcnt(0) lgkmcnt(0)" ::: "memory");
    __syncthreads();
    if (tid < 256) { const float* xp = ps.X + ((size_t)u.pm * 256 + tid) * 4; float t = 0.f;
#pragma unroll
        for (int k = 0; k < 4; ++k) t += __hip_atomic_load(xp + k, __ATOMIC_RELAXED, __HIP_MEMORY_SCOPE_AGENT);
        S[tid] = t; }
    __syncthreads();
#pragma unroll
    for (int sl = 0; sl < 8; ++sl) v[sl] = S[128 * (sl >> 2) + 64 * wr + 16 * (sl & 3) + fr];
}
template <bool X_F32, bool FINAL> struct EpiResNorm {
    static constexpr bool AFTER_DRAIN = true;
    static __device__ __forceinline__ bool keep_acc(const Unit&) { return false; }
    const float* x32; bf16_t* XB; const float* gpost; float* RS; float* out; PanelSum s1, s2;
    __device__ __forceinline__ void operator()(f32x4 (&)[2][2][4][2], const Unit&, int, int, int, int) const {}
    __device__ __forceinline__ void fused(f32x4 (&acc)[2][2][4][2], const Unit& u, int wr, int wc, int fr, int fq, LAS unsigned char* lds, int wid, int lane) const {
        const int row0 = u.pm * BM + wr * 64 + fr, col0 = u.pn * BM + wc * 32 + 8 * fq;
        float v[8];
#pragma unroll
        for (int sl = 0; sl < 8; ++sl) { const int ai = sl >> 2, m = sl & 3; float s = 0.f;
#pragma unroll
            for (int bj = 0; bj < 2; ++bj)
#pragma unroll
                for (int n = 0; n < 2; ++n) { const f32x4 a = acc[ai][bj][m][n]; s += (a[0] * a[0] + a[1] * a[1]) + (a[2] * a[2] + a[3] * a[3]); }
            v[sl] = s; }
        u32x4 xr[4][2]; f32x4 g[2][2];
#pragma unroll
        for (int bj = 0; bj < 2; ++bj)
#pragma unroll
            for (int n = 0; n < 2; ++n) g[bj][n] = *(const f32x4*)(gpost + col0 + bj * HALF + 4 * n);
        if (!X_F32) {
#pragma unroll
            for (int sl = 0; sl < 4; ++sl)
#pragma unroll
                for (int bj = 0; bj < 2; ++bj) xr[sl][bj] = __builtin_nontemporal_load((const u32x4*)(XB + (size_t)(row0 + sl * 16) * DM + col0 + bj * HALF)); }
        panel_sum(s1, v, u, wr, wc, fr, fq, lds, wid, lane);
#pragma unroll
        for (int sl = 0; sl < 8; ++sl) { const int ai = sl >> 2, m = sl & 3; const size_t row = (size_t)(row0 + ai * HALF + m * 16);
            const float ry = __builtin_amdgcn_rsqf(v[sl] * (1.f / DM) + 1e-6f);
#pragma unroll
            for (int bj = 0; bj < 2; ++bj) { f32x4 x0, x1;
                if (X_F32) { x0 = *(const f32x4*)(x32 + row * DM + col0 + bj * HALF); x1 = *(const f32x4*)(x32 + row * DM + col0 + bj * HALF + 4); }
                else { float xf[8]; unpack8(sl < 4 ? xr[sl & 3][bj] : __builtin_nontemporal_load((const u32x4*)(XB + row * DM + col0 + bj * HALF)), xf); x0 = (f32x4){xf[0], xf[1], xf[2], xf[3]}; x1 = (f32x4){xf[4], xf[5], xf[6], xf[7]}; }
                acc[ai][bj][m][0] = x0 + acc[ai][bj][m][0] * ry * g[bj][0]; acc[ai][bj][m][1] = x1 + acc[ai][bj][m][1] * ry * g[bj][1]; } }
        if (FINAL) {
#pragma unroll
            for (int sl = 0; sl < 8; ++sl) { const int ai = sl >> 2, m = sl & 3; float* op = out + (size_t)(row0 + ai * HALF + m * 16) * DM + col0;
#pragma unroll
                for (int bj = 0; bj < 2; ++bj) { *(f32x4*)(op + bj * HALF) = acc[ai][bj][m][0]; *(f32x4*)(op + bj * HALF + 4) = acc[ai][bj][m][1]; } }
            return; }
#pragma unroll
        for (int sl = 0; sl < 8; ++sl) { const int ai = sl >> 2, m = sl & 3; float s = 0.f;
#pragma unroll
            for (int bj = 0; bj < 2; ++bj)
#pragma unroll
                for (int n = 0; n < 2; ++n) { const f32x4 a = acc[ai][bj][m][n]; s += (a[0] * a[0] + a[1] * a[1]) + (a[2] * a[2] + a[3] * a[3]); }
            v[sl] = s; }
        panel_sum(s2, v, u, wr, wc, fr, fq, lds, wid, lane);
#pragma unroll
        for (int sl = 0; sl < 8; ++sl) { const int ai = sl >> 2, m = sl & 3; const size_t row = (size_t)(row0 + ai * HALF + m * 16);
            if (u.pn == 0 && wc == 0 && fq == 0) RS[row] = __builtin_amdgcn_rsqf(v[sl] * (1.f / DM) + 1e-6f);
#pragma unroll
            for (int bj = 0; bj < 2; ++bj) store8(XB + row * DM + col0 + bj * HALF, acc[ai][bj][m][0], acc[ai][bj][m][1]); }
    }
};
}

struct Params { const float* in[20]; float* out; unsigned char* ws; };
enum { I_X = 0, I_PRE_MIX_G, I_POST_MIX_G, I_PRE_FFN_G, I_POST_FFN_G, I_W_IN, I_B_FORGET, I_B_GATE, I_CONV_MIX_W, I_SGU_LN_G, I_SGU_LN_B, I_SGU_W, I_SGU_B,
       I_W_BR_ATT, I_W_BR_CONV, I_W_BR_SGU, I_W_OUT, I_W_FFN_UP, I_CONV_FFN_W, I_W_FFN_DOWN };

__device__ __forceinline__ void tr_item(const float* W, int ldw, int srccol0, int k0, const float* gk, bf16_t* WT, int ldt, int dstrow0, int dstk0, LAS float* scr, int lane) {
    f32x4 v[8];
#pragma unroll
    for (int i = 0; i < 8; ++i) { const int kk = (lane >> 3) + 8 * i; v[i] = __builtin_nontemporal_load((const f32x4*)(W + (size_t)(k0 + kk) * ldw + srccol0 + 4 * (lane & 7))); }
#pragma unroll
    for (int i = 0; i < 8; ++i) { const int kk = (lane >> 3) + 8 * i; const float g = gk ? gk[k0 + kk] : 1.f; LAS float* d = scr + kk * 33 + 4 * (lane & 7);
        d[0] = v[i][0] * g; d[1] = v[i][1] * g; d[2] = v[i][2] * g; d[3] = v[i][3] * g; }
    asm volatile("s_waitcnt lgkmcnt(0)" ::: "memory");
    const int c = lane & 7;
#pragma unroll
    for (int j = 0; j < 4; ++j) { const int n = (lane >> 3) + 8 * j; const LAS float* s = scr + (8 * c) * 33 + n;
        u32x4 o; o.x = pk2(s[0 * 33], s[1 * 33]); o.y = pk2(s[2 * 33], s[3 * 33]); o.z = pk2(s[4 * 33], s[5 * 33]); o.w = pk2(s[6 * 33], s[7 * 33]);
        *(u32x4*)(WT + (size_t)(dstrow0 + n) * ldt + dstk0 + 8 * c) = o; }
    asm volatile("s_waitcnt lgkmcnt(0)" ::: "memory");
}
template <int PARTS>
__device__ __forceinline__ void convert_weights(const Params& p, int l, LAS unsigned char* lds, int gw, int NGW, int lane, int wave) {
    unsigned char* ws = p.ws;
    LAS float* scr = (LAS float*)(lds + 32768 + wave * 8448);
    const size_t ffo = (l & 1) ? (WS_FFN2 - WS_WUP) : 0;
    bf16_t* Win = (bf16_t*)(ws + WS_WIN); bf16_t* Wbr = (bf16_t*)(ws + WS_WBR); bf16_t* Wout = (bf16_t*)(ws + WS_WOUT); bf16_t* Wup = (bf16_t*)(ws + WS_WUP + ffo); bf16_t* Wdn = (bf16_t*)(ws + WS_WDN + ffo);
    constexpr int N_IN = 16 * 184, N_BA = 8 * 32, N_BC = 4 * 32, N_BS = 4 * 32, N_OUT = 16 * 32, N_UP = 16 * 176, N_DN = 44 * 32;
    if constexpr ((PARTS & 1) != 0) {
        const float* w_in = p.in[I_W_IN] + (size_t)l * DM * INW; const float* g1 = p.in[I_PRE_MIX_G] + l * DM;
        for (int r = gw; r < N_IN; r += NGW) { const int kb = r / 184, nb = r % 184, n0 = nb * 32; tr_item(w_in, INW, n0 + (n0 >= 1536 ? 8 : 0), kb * 64, g1, Win, DM, n0, kb * 64, scr, lane); }
        for (int e = gw * 64 + lane; e < 256 * DM / 2; e += NGW * 64) { const int idx = 2 * e, hrow = idx >> 10, k = idx & 1023;
            float a = 0.f, b = 0.f; if (hrow < 8) { a = g1[k] * w_in[(size_t)k * INW + 1536 + hrow]; b = g1[k + 1] * w_in[(size_t)(k + 1) * INW + 1536 + hrow]; }
            *(unsigned*)(Win + (size_t)5888 * DM + idx) = pk2(a, b); }
    }
    if constexpr ((PARTS & 2) != 0) {
        const float* w_out = p.in[I_W_OUT] + (size_t)l * DM * DM;
        const float* w_ba = p.in[I_W_BR_ATT] + (size_t)l * 512 * DM; const float* w_bc = p.in[I_W_BR_CONV] + (size_t)l * 256 * DM; const float* w_bs = p.in[I_W_BR_SGU] + (size_t)l * 256 * DM;
        for (int it = gw; it < N_BA + N_BC + N_BS + N_OUT; it += NGW) { int r = it;
            if (r < N_BA) { const int kb = r / 32, nb = r % 32; tr_item(w_ba, DM, nb * 32, kb * 64, nullptr, Wbr, DM, nb * 32, kb * 64, scr, lane); continue; } r -= N_BA;
            if (r < N_BC) { const int kb = r / 32, nb = r % 32; tr_item(w_bc, DM, nb * 32, kb * 64, nullptr, Wbr, DM, nb * 32, 512 + kb * 64, scr, lane); continue; } r -= N_BC;
            if (r < N_BS) { const int kb = r / 32, nb = r % 32; tr_item(w_bs, DM, nb * 32, kb * 64, nullptr, Wbr, DM, nb * 32, 768 + kb * 64, scr, lane); continue; } r -= N_BS;
            { const int kb = r / 32, nb = r % 32; tr_item(w_out, DM, nb * 32, kb * 64, nullptr, Wout, DM, nb * 32, kb * 64, scr, lane); } }
    }
    if constexpr ((PARTS & 4) != 0) {
        const float* w_up = p.in[I_W_FFN_UP] + (size_t)l * DM * DFF2; const float* w_dn = p.in[I_W_FFN_DOWN] + (size_t)l * DFF * DM; const float* g3 = p.in[I_PRE_FFN_G] + l * DM;
        for (int it = gw; it < N_UP + N_DN; it += NGW) { int r = it;
            if (r < N_UP) { const int kb = r / 176, nb = r % 176, n0 = nb * 32, nh = n0 < DFF ? n0 : n0 - DFF; const int drow = (nh >> 7) * 256 + (n0 < DFF ? 0 : 128) + (nh & 127);
                tr_item(w_up, DFF2, n0, kb * 64, g3, Wup, DM, drow, kb * 64, scr, lane); continue; } r -= N_UP;
            { const int kb = r / 32, nb = r % 32; tr_item(w_dn, DM, nb * 32, kb * 64, nullptr, Wdn, DFF, nb * 32, kb * 64, scr, lane); } }
        const float* sw = p.in[I_SGU_W] + (size_t)l * 4 * 128 * 128; bf16_t* Wm = (bf16_t*)(ws + WS_WM + ffo);
        for (int e = gw * 64 + lane; e < 4 * 128 * 128 / 2; e += NGW * 64) { const int idx = 2 * e, t = (idx >> 7) & 127, s = idx & 127;
            const float a = s <= t ? sw[idx] : 0.f, b = (s + 1) <= t ? sw[idx + 1] : 0.f; *(unsigned*)(Wm + idx) = pk2(a, b); }
    }
}

template <bool X_F32, bool HAS_Y, bool WR_XB, bool WR_LF, bool WR_OUT, int R = 4>
__device__ __forceinline__ void row_phase(const float* x32, const bf16_t* y, const float* gpost, bf16_t* XB, float* RS, float* out, LAS const float* wfl, const float* bfg, float* LF, int gw, int NGW, int lane) {
    for (int row0 = gw; row0 < M; row0 += R * NGW) {
        f32x4 v[R][4]; f32x4 yy[R][4]; bool ok[R]; float r[R];
#pragma unroll
        for (int u = 0; u < R; ++u) { const int row = row0 + u * NGW; ok[u] = row < M; const int rr = ok[u] ? row : row0;
#pragma unroll
            for (int j = 0; j < 4; ++j) {
                if (X_F32) v[u][j] = __builtin_nontemporal_load((const f32x4*)(x32 + (size_t)rr * DM + 256 * j + 4 * lane));
                else { const u32x2 w = *(const u32x2*)(XB + (size_t)rr * DM + 256 * j + 4 * lane); v[u][j] = (f32x4){bflo(w.x), bfhi(w.x), bflo(w.y), bfhi(w.y)}; } }
            if (HAS_Y) {
#pragma unroll
                for (int j = 0; j < 4; ++j) { const u32x2 w = *(const u32x2*)(y + (size_t)rr * DM + 256 * j + 4 * lane); yy[u][j] = (f32x4){bflo(w.x), bfhi(w.x), bflo(w.y), bfhi(w.y)}; } } }
        if (HAS_Y) {
#pragma unroll
            for (int u = 0; u < R; ++u) { const int row = row0 + u * NGW; float ss = 0.f;
#pragma unroll
                for (int j = 0; j < 4; ++j) ss += (yy[u][j][0] * yy[u][j][0] + yy[u][j][1] * yy[u][j][1]) + (yy[u][j][2] * yy[u][j][2] + yy[u][j][3] * yy[u][j][3]);
                ss = wave_sum(ss); const float ry = __builtin_amdgcn_rsqf(ss * (1.f / DM) + 1e-6f);
#pragma unroll
                for (int j = 0; j < 4; ++j) { const f32x4 g = *(const f32x4*)(gpost + 256 * j + 4 * lane); v[u][j] = v[u][j] + yy[u][j] * ry * g;
                    if (WR_OUT && ok[u]) *(f32x4*)(out + (size_t)row * DM + 256 * j + 4 * lane) = v[u][j]; } }
        }
        if (WR_XB) {
#pragma unroll
            for (int u = 0; u < R; ++u) { const int row = row0 + u * NGW; float s2 = 0.f;
#pragma unroll
                for (int j = 0; j < 4; ++j) s2 += (v[u][j][0] * v[u][j][0] + v[u][j][1] * v[u][j][1]) + (v[u][j][2] * v[u][j][2] + v[u][j][3] * v[u][j][3]);
                s2 = wave_sum(s2); r[u] = __builtin_amdgcn_rsqf(s2 * (1.f / DM) + 1e-6f);
                if (ok[u]) { if (lane == 0) RS[row] = r[u];
#pragma unroll
                    for (int j = 0; j < 4; ++j) { u32x2 w; w.x = pk2(v[u][j][0], v[u][j][1]); w.y = pk2(v[u][j][2], v[u][j][3]); *(u32x2*)(XB + (size_t)row * DM + 256 * j + 4 * lane) = w; } } }
            if (WR_LF) {
                float mine[R];
#pragma unroll
                for (int u = 0; u < R; ++u) mine[u] = 0.f;
#pragma unroll
                for (int h = 0; h < 8; ++h) { float pa[R];
#pragma unroll
                    for (int u = 0; u < R; ++u) pa[u] = 0.f;
#pragma unroll
                    for (int j = 0; j < 4; ++j) { const f32x4 w = *(const LAS f32x4*)(wfl + h * DM + 256 * j + 4 * lane);
#pragma unroll
                        for (int u = 0; u < R; ++u) pa[u] += (v[u][j][0] * w[0] + v[u][j][1] * w[1]) + (v[u][j][2] * w[2] + v[u][j][3] * w[3]); }
#pragma unroll
                    for (int u = 0; u < R; ++u) { pa[u] = wave_sum(pa[u]); if (lane == h) mine[u] = pa[u]; } }
#pragma unroll
                for (int u = 0; u < R; ++u) { const int row = row0 + u * NGW;
                    if (lane < 8 && ok[u]) { const float z = mine[u] * r[u] + bfg[lane]; const float lf = fminf(z, 0.f) - __logf(1.f + __expf(-fabsf(z)));
                        const int b = row / SEQ, t = row % SEQ; LF[(size_t)(b * 8 + lane) * SEQ + t] = lf; } }
            }
        }
    }
}
template <bool TO_LDS> __device__ __forceinline__ void build_wf(const Params& p, int l, LAS float* wfl, float* wfg) {
    const float* w_in = p.in[I_W_IN] + (size_t)l * DM * INW; const float* g1 = p.in[I_PRE_MIX_G] + l * DM;
    const int t0 = ltid(); float vals[16];
#pragma unroll
    for (int i = 0; i < 16; ++i) { const int idx = t0 + 512 * i, k = idx >> 3, h = idx & 7; vals[i] = g1[k] * w_in[(size_t)k * INW + 1536 + h]; }
#pragma unroll
    for (int i = 0; i < 16; ++i) { const int idx = t0 + 512 * i, k = idx >> 3, h = idx & 7; if (TO_LDS) wfl[h * DM + k] = vals[i]; else wfg[h * DM + k] = vals[i]; }
    __syncthreads();
}
__device__ __forceinline__ void load_wf(const float* wfg, LAS float* wfl) {
    const int t0 = ltid();
#pragma unroll
    for (int i = 0; i < 4; ++i) *(LAS f32x4*)(wfl + 4 * (t0 + 512 * i)) = *(const f32x4*)(wfg + 4 * (t0 + 512 * i));
    __syncthreads();
}

__device__ __forceinline__ float max3f(float a, float b, float c) { float r; asm("v_max3_f32 %0, %1, %2, %3" : "=v"(r) : "v"(a), "v"(b), "v"(c)); return r; }
constexpr int A_K = 0, A_KBUF = 64 * 144, A_V = 2 * A_KBUF, A_VBUF = 64 * 136, A_CS = 36864, A_WS = A_CS + 16384, A_KX = A_WS + 256;
__device__ __forceinline__ void attn_unit(LAS unsigned char* lds, const bf16_t* __restrict__ H, const bf16_t* __restrict__ Vt, const float* __restrict__ LF, bf16_t* __restrict__ Y, int b, int h, int qb, bool do_scan) {
    const int tid = ltid(), lane = tid & 63, wid = __builtin_amdgcn_readfirstlane(tid >> 6), r32 = lane & 31, hi = lane >> 5;
    const int q0 = qb * 256, NT = (q0 + 256) / 64;
    LAS float* cs = (LAS float*)(lds + A_CS); LAS float* wsum = (LAS float*)(lds + A_WS);
    const size_t rowbase = (size_t)b * SEQ;
    const bf16_t* kg = H + (rowbase + (tid >> 3)) * HW + C_K + h * 64 + (tid & 7) * 8;
    const bf16_t* vg = Vt + (size_t)(h * 64 + (tid >> 3)) * M + rowbase + (tid & 7) * 8;
    const int kw = (tid >> 3) * 144 + (tid & 7) * 16, vw = (tid >> 3) * 136 + (tid & 7) * 16;
    u32x4 kreg = *(const u32x4*)kg, vreg = *(const u32x4*)vg;
    u32x4 kreg2 = *(const u32x4*)(kg + (size_t)64 * HW), vreg2 = *(const u32x4*)(vg + 64);
    const int qpos = q0 + wid * 32 + r32;
    const bf16_t* qg = H + (rowbase + qpos) * HW + C_Q + h * 64 + hi * 8;
    bf16x8 qr[4];
#pragma unroll
    for (int ds = 0; ds < 4; ++ds) qr[ds] = *(const bf16x8*)(qg + ds * 16);
    if (do_scan) {
        const float* lf = LF + (size_t)(b * 8 + h) * SEQ + tid * 8;
        const f32x4 a0 = *(const f32x4*)lf, a1 = *(const f32x4*)(lf + 4);
        float v[8] = {a0[0], a0[1], a0[2], a0[3], a1[0], a1[1], a1[2], a1[3]};
#pragma unroll
        for (int j = 1; j < 8; ++j) v[j] += v[j - 1];
        const float tot = v[7]; float s = tot;
#pragma unroll
        for (int o = 1; o < 64; o <<= 1) { const float t = __shfl_up(s, o); if (lane >= o) s += t; }
        if (lane == 63) wsum[wid] = s;
        __syncthreads();
        float off = s - tot;
        for (int w = 0; w < wid; ++w) off += wsum[w];
        f32x4 c0, c1;
#pragma unroll
        for (int j = 0; j < 4; ++j) { c0[j] = (off + v[j]) * LOG2E; c1[j] = (off + v[4 + j]) * LOG2E; }
        *(LAS f32x4*)(cs + tid * 8) = c0; *(LAS f32x4*)(cs + tid * 8 + 4) = c1;
    }
    *(LAS u32x4*)(lds + A_K + kw) = kreg;
    *(LAS u32x2*)(lds + A_V + vw) = (u32x2){vreg.x, vreg.y}; *(LAS u32x2*)(lds + A_V + vw + 8) = (u32x2){vreg.z, vreg.w};
    __syncthreads();
    const float cref = cs[q0 + 255];
    const float cqr = cs[qpos] - cref;
    const unsigned ONES = hi ? 0u : 0x3F803F80u;
    LAS unsigned* kxw = (LAS unsigned*)(lds + A_KX);
    if (tid * 8 < NT * 64) { const f32x4 ca = *(const LAS f32x4*)(cs + tid * 8), cb = *(const LAS f32x4*)(cs + tid * 8 + 4); unsigned wv[8];
#pragma unroll
        for (int j = 0; j < 8; ++j) { const float b_ = (j < 4 ? ca[j & 3] : cb[j & 3]) - cref; const unsigned h_ = pk2(b_, 0.f) & 0xffffu; const float l_ = b_ - bflo(h_); wv[j] = (h_ | (pk2(l_, 0.f) << 16)) ^ 0x80008000u; }
        *(LAS u32x4*)(kxw + tid * 8) = (u32x4){wv[0], wv[1], wv[2], wv[3]}; *(LAS u32x4*)(kxw + tid * 8 + 4) = (u32x4){wv[4], wv[5], wv[6], wv[7]}; }
    __syncthreads();
    bf16x8 qx;
#define ATT_QX() do { const float a_ = cqr - mrun; const unsigned h_ = pk2(a_, 0.f) & 0xffffu; const float l_ = a_ - bflo(h_); \
        const unsigned w_ = hi ? 0u : (h_ | (pk2(l_, 0.f) << 16)); qx = __builtin_bit_cast(bf16x8, (u32x4){w_, ONES, 0u, 0u}); } while (0)
    f32x16 o0, o1;
#pragma unroll
    for (int r = 0; r < 16; ++r) { o0[r] = 0.f; o1[r] = 0.f; }
    float mrun = 0.f, lrun = 0.f;
    ATT_QX();
    const int wlim = (32 * wid + 31) >> 6;
    for (int t = 0; t < NT; ++t) {
        const int buf = t & 1;
        kreg = kreg2; vreg = vreg2;
        if (t + 2 < NT) { kreg2 = *(const u32x4*)(kg + (size_t)(t + 2) * 64 * HW); vreg2 = *(const u32x4*)(vg + (t + 2) * 64); }
        const int jb = t - (NT - 4);
        if (jb <= wlim) {
        const LAS unsigned char* kb = lds + A_K + buf * A_KBUF + r32 * 144 + hi * 16;
        const LAS unsigned char* vb = lds + A_V + buf * A_VBUF + r32 * 136 + hi * 8;
        bf16x8 kf0[4], kf1[4];
#pragma unroll
        for (int ds = 0; ds < 4; ++ds) { kf0[ds] = *(const LAS bf16x8*)(kb + ds * 32); kf1[ds] = *(const LAS bf16x8*)(kb + 32 * 144 + ds * 32); }
        f32x16 p0, p1;
#pragma unroll
        for (int r = 0; r < 16; ++r) { p0[r] = 0.f; p1[r] = 0.f; }
        bf16x8 kx0, kx1;
        { const unsigned w0 = hi ? 0u : kxw[t * 64 + r32], w1 = hi ? 0u : kxw[t * 64 + 32 + r32];
          kx0 = __builtin_bit_cast(bf16x8, (u32x4){ONES, w0, 0u, 0u}); kx1 = __builtin_bit_cast(bf16x8, (u32x4){ONES, w1, 0u, 0u}); }
        u32x2 vl0[4], vh0[4], vl1[4], vh1[4];
#pragma unroll
        for (int j = 0; j < 4; ++j) { vl0[j] = *(const LAS u32x2*)(vb + j * 32); vh0[j] = *(const LAS u32x2*)(vb + j * 32 + 16);
            vl1[j] = *(const LAS u32x2*)(vb + 32 * 136 + j * 32); vh1[j] = *(const LAS u32x2*)(vb + 32 * 136 + j * 32 + 16); }
        __builtin_amdgcn_s_setprio(1);
        p0 = __builtin_amdgcn_mfma_f32_32x32x16_bf16(kx0, qx, p0, 0, 0, 0); p1 = __builtin_amdgcn_mfma_f32_32x32x16_bf16(kx1, qx, p1, 0, 0, 0);
#pragma unroll
        for (int ds = 0; ds < 4; ++ds) { p0 = __builtin_amdgcn_mfma_f32_32x32x16_bf16(kf0[ds], qr[ds], p0, 0, 0, 0); p1 = __builtin_amdgcn_mfma_f32_32x32x16_bf16(kf1[ds], qr[ds], p1, 0, 0, 0); }
        __builtin_amdgcn_s_setprio(0);
        if (jb >= 0) { const int thr = qpos - (t * 64 + 4 * hi);
#pragma unroll
            for (int rg = 0; rg < 4; ++rg)
#pragma unroll
                for (int i = 0; i < 4; ++i) { if (8 * rg + i > thr) p0[4 * rg + i] = -INFINITY; if (8 * rg + i + 32 > thr) p1[4 * rg + i] = -INFINITY; } }
        float rm = fmaxf(p1[14], p1[15]);
#pragma unroll
        for (int r = 0; r < 14; ++r) rm = max3f(rm, p0[r], p1[r]);
        rm = max3f(rm, p0[14], p0[15]);
        { auto rr = __builtin_amdgcn_permlane32_swap(__builtin_bit_cast(unsigned, rm), __builtin_bit_cast(unsigned, rm), false, false);
          rm = fmaxf(__builtin_bit_cast(float, rr[0]), __builtin_bit_cast(float, rr[1])); }
        if (__any(rm > 8.f)) { const float dl = fmaxf(rm, 0.f); mrun += dl; const float f = __builtin_amdgcn_exp2f(-dl); lrun *= f;
#pragma unroll
            for (int r = 0; r < 16; ++r) { p0[r] -= dl; p1[r] -= dl; o0[r] *= f; o1[r] *= f; }
            ATT_QX(); }
        float ps0 = 0.f, ps1 = 0.f;
#pragma unroll
        for (int r = 0; r < 16; ++r) { p0[r] = __builtin_amdgcn_exp2f(p0[r]); p1[r] = __builtin_amdgcn_exp2f(p1[r]); ps0 += p0[r]; ps1 += p1[r]; }
        lrun += ps0 + ps1;
        bf16x8 pa[4];
        { u32x4 w;
          w.x = pk2(p0[0], p0[1]); w.y = pk2(p0[2], p0[3]); w.z = pk2(p0[4], p0[5]); w.w = pk2(p0[6], p0[7]); pa[0] = __builtin_bit_cast(bf16x8, w);
          w.x = pk2(p0[8], p0[9]); w.y = pk2(p0[10], p0[11]); w.z = pk2(p0[12], p0[13]); w.w = pk2(p0[14], p0[15]); pa[1] = __builtin_bit_cast(bf16x8, w);
          w.x = pk2(p1[0], p1[1]); w.y = pk2(p1[2], p1[3]); w.z = pk2(p1[4], p1[5]); w.w = pk2(p1[6], p1[7]); pa[2] = __builtin_bit_cast(bf16x8, w);
          w.x = pk2(p1[8], p1[9]); w.y = pk2(p1[10], p1[11]); w.z = pk2(p1[12], p1[13]); w.w = pk2(p1[14], p1[15]); pa[3] = __builtin_bit_cast(bf16x8, w); }
#pragma unroll
        for (int j = 0; j < 4; ++j) {
            const bf16x8 vf0 = __builtin_bit_cast(bf16x8, (u32x4){vl0[j].x, vl0[j].y, vh0[j].x, vh0[j].y}), vf1 = __builtin_bit_cast(bf16x8, (u32x4){vl1[j].x, vl1[j].y, vh1[j].x, vh1[j].y});
            o0 = __builtin_amdgcn_mfma_f32_32x32x16_bf16(vf0, pa[j], o0, 0, 0, 0); o1 = __builtin_amdgcn_mfma_f32_32x32x16_bf16(vf1, pa[j], o1, 0, 0, 0); }
        }
        if (t + 1 < NT) { const int nb = buf ^ 1;
            *(LAS u32x4*)(lds + A_K + nb * A_KBUF + kw) = kreg;
            *(LAS u32x2*)(lds + A_V + nb * A_VBUF + vw) = (u32x2){vreg.x, vreg.y}; *(LAS u32x2*)(lds + A_V + nb * A_VBUF + vw + 8) = (u32x2){vreg.z, vreg.w}; }
        __syncthreads();
    }
#undef ATT_QX
    lrun += __shfl_xor(lrun, 32);
    const float inv = 1.f / lrun;
    bf16_t* yp = Y + (rowbase + qpos) * DM + h * 64 + 4 * hi;
#pragma unroll
    for (int rg = 0; rg < 4; ++rg) {
        u32x2 w0, w1; w0.x = pk2(o0[4 * rg] * inv, o0[4 * rg + 1] * inv); w0.y = pk2(o0[4 * rg + 2] * inv, o0[4 * rg + 3] * inv);
        w1.x = pk2(o1[4 * rg] * inv, o1[4 * rg + 1] * inv); w1.y = pk2(o1[4 * rg + 2] * inv, o1[4 * rg + 3] * inv);
        *(u32x2*)(yp + 8 * rg) = w0; *(u32x2*)(yp + 32 + 8 * rg) = w1; }
}

__device__ __forceinline__ void sgu_unit(LAS unsigned char* lds, const Params& p, int l, const bf16_t* __restrict__ H, const bf16_t* __restrict__ Wm, bf16_t* __restrict__ Y, int unit) {
    const int tid = ltid(), lane = tid & 63, wid = __builtin_amdgcn_readfirstlane(tid >> 6), r32 = lane & 31, hi = lane >> 5;
    const size_t rowbase = (size_t)unit * 128;
    const float* lng = p.in[I_SGU_LN_G] + l * 256; const float* lnb = p.in[I_SGU_LN_B] + l * 256; const float* sb = p.in[I_SGU_B] + l * 512;
    LAS bf16_t* VT = (LAS bf16_t*)lds;
    const f32x4 g4 = *(const f32x4*)(lng + 4 * lane), b4 = *(const f32x4*)(lnb + 4 * lane);
    {
        u32x2 w[16];
#pragma unroll
        for (int i = 0; i < 16; ++i) w[i] = *(const u32x2*)(H + (rowbase + wid * 16 + i) * HW + C_VS + 4 * lane);
        f32x4 v[16]; float mu[16], var[16];
#pragma unroll
        for (int i = 0; i < 16; ++i) { v[i] = (f32x4){bflo(w[i].x), bfhi(w[i].x), bflo(w[i].y), bfhi(w[i].y)}; mu[i] = (v[i][0] + v[i][1]) + (v[i][2] + v[i][3]); }
#pragma unroll
        for (int i = 0; i < 16; ++i) mu[i] = wave_sum(mu[i]) * (1.f / 256.f);
#pragma unroll
        for (int i = 0; i < 16; ++i) { v[i] = v[i] - mu[i]; var[i] = (v[i][0] * v[i][0] + v[i][1] * v[i][1]) + (v[i][2] * v[i][2] + v[i][3] * v[i][3]); }
#pragma unroll
        for (int i = 0; i < 16; ++i) var[i] = wave_sum(var[i]) * (1.f / 256.f);
#pragma unroll
        for (int i = 0; i < 16; ++i) { const float rs = __builtin_amdgcn_rsqf(var[i] + 1e-5f); v[i] = v[i] * rs * g4 + b4; }
#pragma unroll
        for (int e = 0; e < 4; ++e) { u32x4 w0, w1;
            w0.x = pk2(v[0][e], v[1][e]); w0.y = pk2(v[2][e], v[3][e]); w0.z = pk2(v[4][e], v[5][e]); w0.w = pk2(v[6][e], v[7][e]);
            w1.x = pk2(v[8][e], v[9][e]); w1.y = pk2(v[10][e], v[11][e]); w1.z = pk2(v[12][e], v[13][e]); w1.w = pk2(v[14][e], v[15][e]);
            LAS u32x4* dst = (LAS u32x4*)(VT + (4 * lane + e) * 136 + wid * 16); dst[0] = w0; dst[1] = w1; }
    }
    __syncthreads();
    const int g = wid >> 1, db = wid & 1;
    const LAS unsigned char* ab = lds + ((g * 64 + db * 32 + r32) * 136 + hi * 8) * 2;
    bf16x8 bfr[4][8]; u32x2 uw[4][4]; float bsv[4];
#pragma unroll
    for (int tb = 0; tb < 4; ++tb) { const int t = tb * 32 + r32; const bf16_t* wrow = Wm + ((size_t)g * 128 + t) * 128 + hi * 8;
#pragma unroll
        for (int ks = 0; ks < 8; ++ks) if (ks < 2 * tb + 2) bfr[tb][ks] = *(const bf16x8*)(wrow + ks * 16);
        bsv[tb] = sb[g * 128 + t];
#pragma unroll
        for (int rg = 0; rg < 4; ++rg) uw[tb][rg] = *(const u32x2*)(H + (rowbase + t) * HW + C_U + g * 64 + db * 32 + 8 * rg + 4 * hi); }
#pragma unroll
    for (int tb = 0; tb < 4; ++tb) {
        f32x16 acc;
#pragma unroll
        for (int r = 0; r < 16; ++r) acc[r] = 0.f;
        const int t = tb * 32 + r32;
#pragma unroll
        for (int ks = 0; ks < 8; ++ks) if (ks < 2 * tb + 2) { const bf16x8 a = *(const LAS bf16x8*)(ab + ks * 32); acc = __builtin_amdgcn_mfma_f32_32x32x16_bf16(a, bfr[tb][ks], acc, 0, 0, 0); }
        const float bs = bsv[tb];
#pragma unroll
        for (int rg = 0; rg < 4; ++rg) { const int d4 = g * 64 + db * 32 + 8 * rg + 4 * hi; const u32x2 u2 = uw[tb][rg];
            u32x2 ow; ow.x = pk2(bflo(u2.x) * (acc[4 * rg] + bs), bfhi(u2.x) * (acc[4 * rg + 1] + bs)); ow.y = pk2(bflo(u2.y) * (acc[4 * rg + 2] + bs), bfhi(u2.y) * (acc[4 * rg + 3] + bs));
            *(u32x2*)(Y + (rowbase + t) * DM + 768 + d4) = ow; }
    }
    __syncthreads();
}

__device__ __forceinline__ void shortconv_items(const Params& p, int l, const bf16_t* __restrict__ H, bf16_t* __restrict__ Y, int gtid, int NTHR) {
    const float* cw = p.in[I_CONV_MIX_W] + l * 3 * 256;
#pragma unroll 2
    for (int it = gtid; it < (M / 2) * 32; it += NTHR) {
        const int cgp = it & 31, rp = it >> 5, t0 = 2 * rp, c0 = cgp * 8;
        float w0[8], w1[8], w2[8];
        { const f32x4 a0 = *(const f32x4*)(cw + c0), a1 = *(const f32x4*)(cw + c0 + 4), b0 = *(const f32x4*)(cw + 256 + c0), b1 = *(const f32x4*)(cw + 256 + c0 + 4), d0 = *(const f32x4*)(cw + 512 + c0), d1 = *(const f32x4*)(cw + 512 + c0 + 4);
#pragma unroll
          for (int e = 0; e < 4; ++e) { w0[e] = a0[e]; w0[4 + e] = a1[e]; w1[e] = b0[e]; w1[4 + e] = b1[e]; w2[e] = d0[e]; w2[4 + e] = d1[e]; } }
        float z[4][8];
        const bool head = (t0 % SEQ) == 0;
#pragma unroll
        for (int r = 0; r < 4; ++r) { const int tr = t0 - 2 + r;
            if (r < 2 && head) {
#pragma unroll
                for (int e = 0; e < 8; ++e) z[r][e] = 0.f; }
            else { float a[8], b[8]; unpack8(*(const u32x4*)(H + (size_t)tr * HW + C_CG + c0), a); unpack8(*(const u32x4*)(H + (size_t)tr * HW + C_HC + c0), b);
#pragma unroll
                for (int e = 0; e < 8; ++e) z[r][e] = a[e] * b[e]; } }
#pragma unroll
        for (int r = 0; r < 2; ++r) { float bg[8]; unpack8(*(const u32x4*)(H + (size_t)(t0 + r) * HW + C_BG + c0), bg); float o[8];
#pragma unroll
            for (int e = 0; e < 8; ++e) o[e] = bg[e] * (w0[e] * z[r][e] + w1[e] * z[r + 1][e] + w2[e] * z[r + 2][e]);
            pg8::store8(Y + (size_t)(t0 + r) * DM + 512 + c0, (f32x4){o[0], o[1], o[2], o[3]}, (f32x4){o[4], o[5], o[6], o[7]}); }
    }
}

__device__ __forceinline__ void convact_items(const Params& p, int l, const bf16_t* __restrict__ H2, bf16_t* __restrict__ ACT, int gtid, int NTHR) {
    const float* cw = p.in[I_CONV_FFN_W] + (size_t)l * 3 * DFF2;
    constexpr int NCG = DFF / 8;
    for (int it = gtid; it < (M / 8) * NCG; it += NTHR) {
        const int cgp = it % NCG, rgp = it / NCG, t0 = rgp * 8, c0 = cgp * 8;
        float wa[3][8], wb[3][8];
#pragma unroll
        for (int k = 0; k < 3; ++k)
#pragma unroll
            for (int e = 0; e < 8; ++e) { wa[k][e] = cw[k * DFF2 + c0 + e]; wb[k][e] = cw[k * DFF2 + DFF + c0 + e]; }
        float a0[8], a1[8], b0[8], b1[8];
        if ((t0 % SEQ) == 0) {
#pragma unroll
            for (int e = 0; e < 8; ++e) { a0[e] = 0.f; a1[e] = 0.f; b0[e] = 0.f; b1[e] = 0.f; } }
        else { unpack8(*(const u32x4*)(H2 + (size_t)(t0 - 2) * DFF2 + c0), a0); unpack8(*(const u32x4*)(H2 + (size_t)(t0 - 1) * DFF2 + c0), a1);
               unpack8(*(const u32x4*)(H2 + (size_t)(t0 - 2) * DFF2 + DFF + c0), b0); unpack8(*(const u32x4*)(H2 + (size_t)(t0 - 1) * DFF2 + DFF + c0), b1); }
#pragma unroll
        for (int r = 0; r < 8; ++r) { float a2[8], b2[8];
            unpack8(*(const u32x4*)(H2 + (size_t)(t0 + r) * DFF2 + c0), a2); unpack8(*(const u32x4*)(H2 + (size_t)(t0 + r) * DFF2 + DFF + c0), b2);
            float o[8];
#pragma unroll
            for (int e = 0; e < 8; ++e) { const float ca = wa[0][e] * a0[e] + wa[1][e] * a1[e] + wa[2][e] * a2[e]; const float cb = wb[0][e] * b0[e] + wb[1][e] * b1[e] + wb[2][e] * b2[e];
                o[e] = gelu_t(ca) * cb; a0[e] = a1[e]; a1[e] = a2[e]; b0[e] = b1[e]; b1[e] = b2[e]; }
            pg8::store8(ACT + (size_t)(t0 + r) * DFF + c0, (f32x4){o[0], o[1], o[2], o[3]}, (f32x4){o[4], o[5], o[6], o[7]}); }
    }
}


__device__ __forceinline__ void conv_fixup(const Params& p, int l, const bf16_t* HALO, bf16_t* ACT, int pm) {
    if ((pm & 15) == 0) return;
    const int t = ltid(); const float* cw = p.in[I_CONV_FFN_W] + (size_t)l * 3 * DFF2;
    if (t < DFF / 8) { const int c0 = t * 8;
        float o0[8], o1[8], av[2][8], bv[2][8];
#pragma unroll
        for (int half = 0; half < 2; ++half) { const int cc = half * DFF + c0;
            float r0[8], r1[8], p254[8], p255[8];
            unpack8(*(const u32x4*)(HALO + ((size_t)pm * 4 + 0) * DFF2 + cc), r0); unpack8(*(const u32x4*)(HALO + ((size_t)pm * 4 + 1) * DFF2 + cc), r1);
            unpack8(*(const u32x4*)(HALO + ((size_t)(pm - 1) * 4 + 2) * DFF2 + cc), p254); unpack8(*(const u32x4*)(HALO + ((size_t)(pm - 1) * 4 + 3) * DFF2 + cc), p255);
#pragma unroll
            for (int e = 0; e < 8; ++e) { const float w0 = cw[cc + e], w1 = cw[DFF2 + cc + e], w2 = cw[2 * DFF2 + cc + e];
                const float c_0 = w2 * r0[e] + w1 * p255[e] + w0 * p254[e], c_1 = w2 * r1[e] + w1 * r0[e] + w0 * p255[e];
                if (half == 0) { av[0][e] = c_0; av[1][e] = c_1; } else { bv[0][e] = c_0; bv[1][e] = c_1; } } }
#pragma unroll
        for (int e = 0; e < 8; ++e) { o0[e] = gelu_t(av[0][e]) * bv[0][e]; o1[e] = gelu_t(av[1][e]) * bv[1][e]; }
        pg8::store8(ACT + (size_t)(pm * 256) * DFF + c0, (f32x4){o0[0], o0[1], o0[2], o0[3]}, (f32x4){o0[4], o0[5], o0[6], o0[7]});
        pg8::store8(ACT + (size_t)(pm * 256 + 1) * DFF + c0, (f32x4){o1[0], o1[1], o1[2], o1[3]}, (f32x4){o1[4], o1[5], o1[6], o1[7]}); }
    asm volatile("s_waitcnt vmcnt(0)" ::: "memory");
    __syncthreads();
}

#define XB_TMO      128
#define XB_XCNT(j)  (256  + 64 * (j))
#define XB_XSUB(j)  (1280 + 64 * (j))
#define XB_XGEN(j)  (2304 + 64 * (j))
#define XB_TOP      3328
#define XB_TOPGEN   3392
#define XCD_BAR_WORDS 3456
#define XB_SPIN_CAP (1u << 22)
__device__ __forceinline__ unsigned xb_ld(unsigned* p)              { return __hip_atomic_load(p, __ATOMIC_RELAXED, __HIP_MEMORY_SCOPE_AGENT); }
__device__ __forceinline__ unsigned xb_add(unsigned* p, unsigned v) { return __hip_atomic_fetch_add(p, v, __ATOMIC_RELAXED, __HIP_MEMORY_SCOPE_AGENT); }
__device__ __forceinline__ unsigned xb_xcc_id() { return (unsigned)__builtin_amdgcn_s_getreg((3 << 11) | 20) & 0xFu; }
#define XB_SPIN(cond, bar) do { unsigned _sp = 0; while (cond) { __builtin_amdgcn_s_sleep(1); \
    if ((++_sp & 255u) == 0u) { if (xb_ld(&(bar)[XB_TMO])) break; if (_sp > XB_SPIN_CAP) { atomicAdd(&(bar)[XB_TMO], 1u); break; } } } } while (0)
struct XcdBarrier { unsigned* bar; unsigned x; volatile LAS unsigned* st; };
__device__ __forceinline__ XcdBarrier xcd_barrier_post(unsigned* bar, volatile LAS unsigned* st) {
    XcdBarrier b; b.bar = bar; b.x = xb_xcc_id(); b.st = st;
    if (threadIdx.x == 0) (void)xb_add(&bar[XB_XCNT(b.x)], 1u);
    return b;
}
__device__ __forceinline__ void xcd_barrier_complete(unsigned* bar, unsigned x, unsigned& nloc, unsigned& nx) {
    const unsigned G = gridDim.x * gridDim.y * gridDim.z;
    unsigned sum, cnt, mine, sp = 0u;
    for (;;) {
        sum = 0u; cnt = 0u; mine = 0u;
#pragma unroll
        for (unsigned j = 0; j < 16; ++j) { const unsigned c = xb_ld(&bar[XB_XCNT(j)]); sum += c; cnt += (c > 0u) ? 1u : 0u; mine = (j == x) ? c : mine; }
        if (sum == G) break;
        __builtin_amdgcn_s_sleep(1);
        if ((++sp & 255u) == 0u) { if (xb_ld(&bar[XB_TMO])) break; if (sp > XB_SPIN_CAP) { atomicAdd(&bar[XB_TMO], 1u); break; } }
    }
    nloc = mine > 0u ? mine : 1u; nx = cnt > 0u ? cnt : 1u;
}
__device__ __forceinline__ void xcd_barrier(const XcdBarrier& b) {
    asm volatile("s_waitcnt vmcnt(0)" ::: "memory");
    __syncthreads();
    if (threadIdx.x == 0) {
        unsigned* bar = b.bar;
        __builtin_amdgcn_s_waitcnt(0);
        unsigned nloc = b.st[0], nx = b.st[1];
        if (nloc == 0u) { xcd_barrier_complete(bar, b.x, nloc, nx); b.st[0] = nloc; b.st[1] = nx; }
        const unsigned old = xb_add(&bar[XB_XSUB(b.x)], 1u);
        const unsigned gen = old / nloc;
        if (old + 1u == (gen + 1u) * nloc) {
            __builtin_amdgcn_fence(__ATOMIC_RELEASE, "agent");
            asm volatile("s_waitcnt vmcnt(0)" ::: "memory");
            const unsigned og = xb_add(&bar[XB_TOP], 1u);
            const unsigned tg = og / nx;
            if (og + 1u == (tg + 1u) * nx) xb_add(&bar[XB_TOPGEN], 1u);
            else XB_SPIN(xb_ld(&bar[XB_TOPGEN]) == tg, bar);
            __builtin_amdgcn_fence(__ATOMIC_ACQUIRE, "agent");
            xb_add(&bar[XB_XGEN(b.x)], 1u);
            asm volatile("s_waitcnt vmcnt(0)" ::: "memory");
        } else {
            XB_SPIN(xb_ld(&bar[XB_XGEN(b.x)]) == gen, bar);
            __builtin_amdgcn_fence(__ATOMIC_ACQUIRE, "agent");
            asm volatile("s_waitcnt vmcnt(0)" ::: "memory");
        }
    }
    __syncthreads();
}
constexpr int EX_OFF = 131072 + 1024;
constexpr int MISC_OFF = 131072 + 512;
constexpr size_t WS_BAR = 65536;

__global__ void __launch_bounds__(512, 2) fwd_megakernel(Params p_unused) {
    extern __shared__ __attribute__((aligned(16))) unsigned char lds_raw[];
    cg::grid_group grid = cg::this_grid();
    LAS unsigned char* lds = (LAS unsigned char*)lds_raw;
    LAS float* wfl = (LAS float*)lds;
    (void)p_unused;
    if (threadIdx.x < 64) ((LAS unsigned*)(lds + MISC_OFF))[threadIdx.x] = 0u;
    __syncthreads();
    { auto kz = __builtin_amdgcn_kernarg_segment_ptr(); unsigned char* wz = ((const Params*)kz)->ws; const int gz = blockIdx.x * 512 + threadIdx.x;
      if (gz < (384 - 64) * 1024 / 16) ((u32x4*)(wz + 65536))[gz] = (u32x4){0u, 0u, 0u, 0u}; }
    grid.sync();
    { auto ka0 = __builtin_amdgcn_kernarg_segment_ptr(); const Params& p0 = *(const Params*)ka0; (void)xcd_barrier_post((unsigned*)(p0.ws + WS_BAR), (volatile LAS unsigned*)(lds + MISC_OFF)); }
#define GRID_BAR() do { auto kb_ = __builtin_amdgcn_kernarg_segment_ptr(); asm volatile("" : "+s"(kb_)); XcdBarrier b_; b_.bar = (unsigned*)(((const Params*)kb_)->ws + WS_BAR); b_.x = xb_xcc_id(); \
        b_.st = (volatile LAS unsigned*)(lds + MISC_OFF); xcd_barrier(b_); } while (0)
#define PHASE_BEGIN \
    auto ka_ = __builtin_amdgcn_kernarg_segment_ptr(); asm volatile("" : "+s"(ka_)); \
    const Params& p = *(const Params*)ka_; \
    int l = l_loop; asm volatile("" : "+s"(l)); \
    const int tid = ltid(), lane = tid & 63, wave = __builtin_amdgcn_readfirstlane(tid >> 6); \
    int G = gridDim.x, bx = blockIdx.x; asm volatile("" : "+s"(G), "+s"(bx)); \
    const int gw = bx * 8 + wave, NGW = G * 8, gtid = bx * 512 + tid, NTHR = G * 512; \
    unsigned char* ws = p.ws; float* LF = (float*)(ws + WS_LF); float* RS = (float*)(ws + WS_RS); (void)RS; \
    bf16_t* Win = (bf16_t*)(ws + WS_WIN); bf16_t* Wbr = (bf16_t*)(ws + WS_WBR); bf16_t* Wout = (bf16_t*)(ws + WS_WOUT); const size_t ffo = (l & 1) ? (WS_FFN2 - WS_WUP) : 0; bf16_t* Wup = (bf16_t*)(ws + WS_WUP + ffo); bf16_t* Wdn = (bf16_t*)(ws + WS_WDN + ffo); bf16_t* Wm = (bf16_t*)(ws + WS_WM + ffo); \
    bf16_t* XN = (bf16_t*)(ws + WS_XN); bf16_t* Y = (bf16_t*)(ws + WS_Y); bf16_t* MG = (bf16_t*)(ws + WS_MG); bf16_t* ACT = (bf16_t*)(ws + WS_ACT); \
    bf16_t* Vt = (bf16_t*)(ws + WS_VT); bf16_t* H = (bf16_t*)(ws + WS_H); bf16_t* H2 = H; bf16_t* YO = H; float* xres = p.out; \
    (void)l; (void)lane; (void)gw; (void)NGW; (void)gtid; (void)NTHR; (void)LF; (void)Win; (void)Wbr; (void)Wout; (void)Wup; (void)Wdn; (void)Wm; (void)XN; (void)Y; (void)MG; (void)ACT; (void)Vt; (void)H; (void)H2; (void)YO; (void)xres;

    { const int l_loop = 0; PHASE_BEGIN
      row_phase<true, false, true, false, false>(p.in[I_X], nullptr, nullptr, XN, RS, nullptr, nullptr, nullptr, nullptr, gw, NGW, lane);
      convert_weights<7>(p, 0, lds, gw, NGW, lane, wave); }
    GRID_BAR();

    for (int l_loop = 0; l_loop < DEPTH; ++l_loop) {
        { PHASE_BEGIN pg8::SchedIn S{XN, Win, G, bx}; pg8::EpiIn E{H, Vt, p.in[I_B_GATE] + l * 3 * DM, RS, LF, p.in[I_B_FORGET] + l * 8};
          pg8::gemm_phase<pg8::EpiIn, pg8::SchedIn, true>(lds, DM, DM, S, E); }
        GRID_BAR();
        { PHASE_BEGIN
          for (int u = bx; u < 256; u += G) { const int bh = (u & 7) * 4 + (u >> 6), s = (u >> 3) & 7;     attn_unit(lds, H, Vt, LF, Y, bh >> 3, bh & 7, s, true); attn_unit(lds, H, Vt, LF, Y, bh >> 3, bh & 7, 15 - s, false); }
          __syncthreads();
          for (int u = bx; u < 128; u += G) sgu_unit(lds, p, l, H, Wm, Y, u);
          shortconv_items(p, l, H, Y, gtid, NTHR);
 }
        GRID_BAR();
        { PHASE_BEGIN pg8::SchedBr S{Y, Wbr, G, bx}; pg8::EpiBr E{H, MG};
          pg8::gemm_phase<pg8::EpiBr, pg8::SchedBr, true>(lds, DM, DM, S, E); }
        GRID_BAR();
        { PHASE_BEGIN pg8::SchedPlain S{MG, Wout, DM, DM, 64, 4, 16, G, bx};
          unsigned* cb = (unsigned*)(ws + WS_CNT) + (size_t)(4 * l) * 4096;
          const pg8::PanelSum s1{(float*)(ws + WS_X1), cb}, s2{(float*)(ws + WS_X2), cb + 4096};
          { pg8::EpiResNorm<false, false> E{nullptr, XN, p.in[I_POST_MIX_G] + l * DM, RS, nullptr, s1, s2}; pg8::gemm_phase<pg8::EpiResNorm<false, false>, pg8::SchedPlain, false>(lds, DM, DM, S, E); } }
        GRID_BAR();
        { PHASE_BEGIN pg8::SchedPlain S{XN, Wup, DM, DM, 64, 22, 16, G, bx}; pg8::EpiConv E{ACT, (bf16_t*)(ws + WS_HALO), p.in[I_CONV_FFN_W] + (size_t)l * 3 * DFF2, RS, lds + EX_OFF};
          pg8::gemm_phase<pg8::EpiConv, pg8::SchedPlain, true, true>(lds, DM, DM, S, E);
          if (G == 256 && bx >= 128 && l + 1 < DEPTH) convert_weights<7>(p, l + 1, lds, (bx - 128) * 8 + wave, 128 * 8, lane, wave); }
        GRID_BAR();
        { PHASE_BEGIN pg8::SchedPlain S{ACT, Wdn, DFF, DFF, 64, 4, 44, G, bx};
          { pg8::Unit u0; if (S.next(0, u0)) conv_fixup(p, l, (const bf16_t*)(ws + WS_HALO), ACT, u0.pm); }
          unsigned* cb = (unsigned*)(ws + WS_CNT) + (size_t)(4 * l + 2) * 4096;
          const pg8::PanelSum s1{(float*)(ws + WS_X1), cb}, s2{(float*)(ws + WS_X2), cb + 4096};
          if (l + 1 < DEPTH) { pg8::EpiResNorm<false, false> E{nullptr, XN, p.in[I_POST_FFN_G] + l * DM, RS, nullptr, s1, s2}; pg8::gemm_phase<pg8::EpiResNorm<false, false>, pg8::SchedPlain, false>(lds, DFF, DFF, S, E); }
          else { pg8::EpiResNorm<false, true> E{nullptr, XN, p.in[I_POST_FFN_G] + l * DM, nullptr, xres, s1, s2}; pg8::gemm_phase<pg8::EpiResNorm<false, true>, pg8::SchedPlain, false>(lds, DFF, DFF, S, E); } }
        if (l_loop + 1 < DEPTH) {
            GRID_BAR();
            if (gridDim.x != 256) { { PHASE_BEGIN convert_weights<7>(p, l + 1, lds, gw, NGW, lane, wave); } GRID_BAR(); }
        }
    }
#undef PHASE_BEGIN
#undef GRID_BAR
}

extern "C" void kernel_launch(void* const* d_in, const int* in_sizes, int n_in, void* d_out, int out_size, void* d_ws, size_t ws_size, hipStream_t stream) {
    static int grid = 0;
    if (grid == 0) {
        if (n_in != 20 || out_size != M * DM || ws_size < WS_END) { fprintf(stderr, "kernel_launch: unexpected problem (n_in %d, out %d, ws %zu)\n", n_in, out_size, ws_size); grid = -1; return; }
        int dev = 0, cus = 0, per_cu = 0;
        hipGetDevice(&dev); hipDeviceGetAttribute(&cus, hipDeviceAttributeMultiprocessorCount, dev);
        if (hipFuncSetAttribute((const void*)fwd_megakernel, hipFuncAttributeMaxDynamicSharedMemorySize, LDS_BYTES) != hipSuccess) { fprintf(stderr, "kernel_launch: hipFuncSetAttribute failed\n"); grid = -1; return; }
        hipOccupancyMaxActiveBlocksPerMultiprocessor(&per_cu, (const void*)fwd_megakernel, 512, LDS_BYTES);
        if (per_cu < 1) { fprintf(stderr, "kernel_launch: occupancy query says %d blocks per CU\n", per_cu); per_cu = 1; }
        (void)hipGetLastError();
        grid = cus;
    }
    if (grid < 0) return;
    Params p{};
    for (int i = 0; i < 20; ++i) p.in[i] = (const float*)d_in[i];
    p.out = (float*)d_out; p.ws = (unsigned char*)d_ws;
    void* args[] = {&p};
    hipError_t e = hipLaunchCooperativeKernel((const void*)fwd_megakernel, dim3(grid), dim3(512), args, LDS_BYTES, stream);
    if (e != hipSuccess) fprintf(stderr, "cooperative launch failed: %s (grid %d)\n", hipGetErrorString(e), grid);
}
```

```cpp
#include <hip/hip_runtime.h>
#include <hip/hip_cooperative_groups.h>
#include <cstdio>
#include <cstdint>
namespace cg = cooperative_groups;

#define LAS __attribute__((address_space(3)))
typedef unsigned short bf16_t;
typedef short bf16x8 __attribute__((ext_vector_type(8)));
typedef float f32x4 __attribute__((ext_vector_type(4)));
typedef float f32x16 __attribute__((ext_vector_type(16)));
typedef unsigned u32x4 __attribute__((ext_vector_type(4)));
typedef unsigned u32x2 __attribute__((ext_vector_type(2)));
typedef float f32x2_t __attribute__((ext_vector_type(2)));
typedef __bf16 bf16x2_t __attribute__((ext_vector_type(2)));

constexpr int DM = 1024, SEQ = 4096, NB = 4, M = NB * SEQ, DEPTH = 4;
constexpr int INW = 5896;
constexpr int HW = 5888;
constexpr int DFF = 2816, DFF2 = 5632;
constexpr int C_Q = 0, C_K = 512, C_V = 1024, C_BG = 1536, C_CG = 1792, C_HC = 2048, C_U = 2304, C_VS = 2560, C_GATE = 2816;
constexpr float LOG2E = 1.4426950408889634f;
constexpr float QSCALE = 0.125f * LOG2E;

constexpr size_t MiB = 1u << 20;
constexpr size_t WS_LF = 1 * MiB;
constexpr size_t WS_RS = 1 * MiB + 512 * 1024;
constexpr size_t WS_CNT = 128 * 1024;
constexpr size_t WS_X1 = 512 * 1024, WS_X2 = 768 * 1024;
constexpr size_t WS_WFG = 1 * MiB + 768 * 1024;
constexpr size_t WS_WIN = 2 * MiB;
constexpr size_t WS_WBR = 14 * MiB;
constexpr size_t WS_WOUT = 16 * MiB;
constexpr size_t WS_WUP = 18 * MiB;
constexpr size_t WS_WDN = 29 * MiB;
constexpr size_t WS_WM = 35 * MiB;
constexpr size_t WS_XN = 36 * MiB;
constexpr size_t WS_Y = 68 * MiB;
constexpr size_t WS_MG = 100 * MiB;
constexpr size_t WS_ACT = 68 * MiB;
constexpr size_t WS_VT = 132 * MiB;
constexpr size_t WS_H = 156 * MiB;
constexpr size_t WS_HALO = 340 * MiB;
constexpr size_t WS_FFN2 = 344 * MiB;
constexpr size_t WS_FFN_BYTES = 35 * MiB + 128 * 1024 - 18 * MiB;
constexpr size_t WS_END = 362 * MiB;

constexpr int LDS_BYTES = 147456;

__device__ __forceinline__ unsigned pk2(float lo, float hi) { f32x2_t v = {lo, hi}; bf16x2_t b = __builtin_convertvector(v, bf16x2_t); return __builtin_bit_cast(unsigned, b); }
__device__ __forceinline__ float bflo(unsigned w) { return __builtin_bit_cast(float, w << 16); }
__device__ __forceinline__ float bfhi(unsigned w) { return __builtin_bit_cast(float, w & 0xffff0000u); }
__device__ __forceinline__ float gelu_t(float x) { const float u = x * (1.f + 0.044715f * x * x); const float e = __builtin_amdgcn_exp2f(-2.3022081981f * u); return x * __builtin_amdgcn_rcpf(1.f + e); }
__device__ __forceinline__ float inv_sigmoid_f(float z) { return fminf(1.f + __builtin_amdgcn_exp2f(-LOG2E * z), 1e6f); }
__device__ __forceinline__ float sigmoid_f(float z) { return __builtin_amdgcn_rcpf(1.f + __builtin_amdgcn_exp2f(-LOG2E * z)); }
__device__ __forceinline__ float wave_sum(float v) {
#pragma unroll
    for (int o = 1; o < 64; o <<= 1) v += __shfl_xor(v, o);
    return v;
}
__device__ __forceinline__ void unpack8(u32x4 w, float* f) { f[0] = bflo(w.x); f[1] = bfhi(w.x); f[2] = bflo(w.y); f[3] = bfhi(w.y); f[4] = bflo(w.z); f[5] = bfhi(w.z); f[6] = bflo(w.w); f[7] = bfhi(w.w); }

__device__ __forceinline__ int ltid() { int t = threadIdx.x; asm volatile("" : "+v"(t)); return t; }
template <class T> __device__ __forceinline__ T* launder(T* p) { asm volatile("" : "+s"(p)); return p; }

namespace pg8 {
constexpr int BM = 256, BK = 64, HALF = 128, HTB = HALF * BK * 2, STAGE_BYTES = 8 * HTB, NXCD = 8, WGM = 4;
__host__ __device__ __forceinline__ int lds_byte(int r, int c) { const int st = (r >> 4) * 2 + (c >> 5), rr = r & 15, cc = c & 31, ob = rr * 64 + cc * 2; return st * 1024 + (ob ^ (((ob >> 9) & 1) << 5)); }
__host__ __device__ __forceinline__ void stage_rc(int b, int& R, int& C) { const int st = b / 1024, sb = b % 1024, swz = sb ^ (((sb >> 9) & 1) << 5); R = (st >> 1) * 16 + swz / 64; C = (st & 1) * 32 + (swz % 64) / 2; }
__host__ __device__ __forceinline__ int perm32(int rho) { const int n = rho >> 4, i = rho & 15; return 8 * (i >> 2) + 4 * n + (i & 3); }

struct Unit { const char* a; const char* b; int nt, pm, pn, kind; };

__device__ __forceinline__ void order_map(int L, int nM, int nN, int& pm, int& pn) {
    const int nwg = nM * nN; int wgid = L;
    { const int q = nwg / NXCD, r = nwg % NXCD, xcd = wgid % NXCD, off = wgid / NXCD; wgid = (xcd < r ? xcd * (q + 1) : r * (q + 1) + (xcd - r) * q) + off; }
    const int nig = WGM * nN, gid = wgid / nig, fm = gid * WGM, gsz = (nM - fm) < WGM ? (nM - fm) : WGM;
    pm = fm + ((wgid % nig) % gsz); pn = (wgid % nig) / gsz;
}

template <class Epi, class Sched, bool ALIGN_EPI, bool APERM = false>
__device__ __forceinline__ void gemm_phase(LAS unsigned char* lds, const int lda, const int ldb, const Sched& S, const Epi& E) {
    const int tid = ltid(), wid = __builtin_amdgcn_readfirstlane(tid >> 6), lane = tid & 63, wr = wid >> 2, wc = wid & 3, fr = lane & 15, fq = lane >> 4;
    unsigned voffA[2], voffA1[2], voffB[2];
#pragma unroll
    for (int i = 0; i < 2; ++i) { int R, C; stage_rc(tid * 16 + i * 8192, R, C); const int Rb = (R & ~31) + perm32(R & 31);
        const int T0 = 8 * (16 * (R >> 6) + (R & 15)) + ((R >> 4) & 3);
        voffA[i] = (unsigned)((APERM ? T0 : R) * lda + C) * 2u; voffA1[i] = (unsigned)((APERM ? T0 + 4 : R) * lda + C) * 2u; voffB[i] = (unsigned)(Rb * ldb + C) * 2u; }
#define PG8_AH(ptr) (APERM ? (ptr) : (ptr) + hstepA)
    const size_t kstep = (size_t)(BK * 2);
    const size_t hstepA = (size_t)HALF * lda * 2, hstepB = (size_t)HALF * ldb * 2;
    const unsigned ldsw = (unsigned)wid * 1024u;
    const int aoff = lds_byte(wr * 64 + fr, fq * 8), boff = lds_byte(wc * 32 + fr, fq * 8);
#define PG8_SA(b, h) (((b) * 2 + (h)) * HTB)
#define PG8_SB(b, h) ((4 + (b) * 2 + (h)) * HTB)
#define PG8_STAGE(bufoff, gbase, voff) do { _Pragma("unroll") for (int _i = 0; _i < 2; ++_i) \
        __builtin_amdgcn_global_load_lds((const unsigned*)((const char*)(gbase) + (voff)[_i]), (LAS unsigned*)(lds + (bufoff) + ldsw + _i * 8192), 16, 0, 0); } while (0)
#define PG8_LDA(dst, b, h) do { _Pragma("unroll") for (int m = 0; m < 4; ++m) _Pragma("unroll") for (int k = 0; k < 2; ++k) dst[m][k] = *(const LAS bf16x8*)(lds + PG8_SA(b, h) + aoff + m * 2048 + k * 1024); } while (0)
#define PG8_LDB(dst, b, h) do { _Pragma("unroll") for (int n = 0; n < 2; ++n) _Pragma("unroll") for (int k = 0; k < 2; ++k) dst[n][k] = *(const LAS bf16x8*)(lds + PG8_SB(b, h) + boff + n * 2048 + k * 1024); } while (0)
#define PG8_MMA(ai, bj, At, Bt) do { __builtin_amdgcn_s_setprio(1); _Pragma("unroll") for (int m = 0; m < 4; ++m) _Pragma("unroll") for (int n = 0; n < 2; ++n) _Pragma("unroll") for (int k = 0; k < 2; ++k) \
        acc[ai][bj][m][n] = __builtin_amdgcn_mfma_f32_16x16x32_bf16(Bt[n][k], At[m][k], acc[ai][bj][m][n], 0, 0, 0); __builtin_amdgcn_s_setprio(0); } while (0)
#define PG8_WAIT_V(n) asm volatile("s_waitcnt vmcnt(" #n ")" ::: "memory")
#define PG8_WAIT_L(n) asm volatile("s_waitcnt lgkmcnt(" #n ")" ::: "memory")
#define PG8_BAR __builtin_amdgcn_s_barrier()
#define PG8_SCHED __builtin_amdgcn_sched_barrier(0)
    Unit cur, nxt; int ui = 0;
    if (!S.next(0, cur)) return;
    f32x4 acc[2][2][4][2];
#pragma unroll
    for (int a = 0; a < 2; ++a)
#pragma unroll
        for (int b = 0; b < 2; ++b)
#pragma unroll
            for (int m = 0; m < 4; ++m)
#pragma unroll
                for (int n = 0; n < 2; ++n) acc[a][b][m][n] = (f32x4){0.f, 0.f, 0.f, 0.f};
    bf16x8 At[4][2], B0[2][2], B1[2][2];
    const char* cA = cur.a; const char* cB = cur.b;
    PG8_STAGE(PG8_SB(0, 0), cB, voffB); PG8_STAGE(PG8_SB(0, 1), cB + hstepB, voffB); PG8_STAGE(PG8_SA(0, 0), cA, voffA); PG8_STAGE(PG8_SA(0, 1), PG8_AH(cA), voffA1);
    if (wr == 1) PG8_BAR;
    PG8_WAIT_V(2); PG8_BAR;
    PG8_STAGE(PG8_SB(1, 0), cB + kstep, voffB); PG8_STAGE(PG8_SA(1, 0), cA + kstep, voffA); PG8_STAGE(PG8_SB(1, 1), cB + hstepB + kstep, voffB);
    PG8_WAIT_V(6); PG8_BAR;
    for (;;) {
        const bool has_next = S.next(ui + 1, nxt);
        const char* nA = has_next ? nxt.a : cA; const char* nB = has_next ? nxt.b : cB;
        const int nt = cur.nt;
        for (int t = 0; t < nt; t += 2) {
            const bool last = (t == nt - 2);
            const char* a1 = cA + (size_t)(t + 1) * kstep;
            const char* a2 = last ? nA : cA + (size_t)(t + 2) * kstep; const char* b2 = last ? nB : cB + (size_t)(t + 2) * kstep;
            const char* a3 = a2 + kstep; const char* b3 = b2 + kstep;
            PG8_LDB(B0, 0, 0); PG8_LDB(B1, 0, 1); PG8_SCHED; PG8_LDA(At, 0, 0); PG8_STAGE(PG8_SA(1, 1), PG8_AH(a1), voffA1);
            PG8_WAIT_V(8); PG8_WAIT_L(0); PG8_BAR; PG8_MMA(0, 0, At, B0); PG8_MMA(0, 1, At, B1); PG8_BAR; PG8_SCHED;
            PG8_LDA(At, 0, 1); PG8_STAGE(PG8_SB(0, 0), b2, voffB); PG8_STAGE(PG8_SB(0, 1), b2 + hstepB, voffB); PG8_STAGE(PG8_SA(0, 0), a2, voffA);
            PG8_WAIT_V(8); PG8_WAIT_L(0); PG8_BAR; PG8_MMA(1, 0, At, B0); PG8_MMA(1, 1, At, B1); PG8_BAR; PG8_SCHED;
            PG8_LDB(B0, 1, 0); PG8_LDB(B1, 1, 1); PG8_SCHED; PG8_LDA(At, 1, 0); PG8_STAGE(PG8_SA(0, 1), PG8_AH(a2), voffA1);
            PG8_WAIT_V(8); PG8_WAIT_L(0); PG8_BAR; PG8_MMA(0, 0, At, B0); PG8_MMA(0, 1, At, B1); PG8_BAR; PG8_SCHED;
            PG8_LDA(At, 1, 1); PG8_STAGE(PG8_SB(1, 0), b3, voffB); PG8_STAGE(PG8_SB(1, 1), b3 + hstepB, voffB); PG8_STAGE(PG8_SA(1, 0), a3, voffA);
            PG8_WAIT_V(8); PG8_WAIT_L(0); PG8_BAR; PG8_MMA(1, 0, At, B0); PG8_MMA(1, 1, At, B1); PG8_BAR; PG8_SCHED;
        }
        if constexpr (ALIGN_EPI) { if (wr == 0) PG8_BAR; }
        if constexpr (!Epi::AFTER_DRAIN) E(acc, cur, wr, wc, fr, fq);
        if (!has_next) break;
        if (!Epi::keep_acc(cur)) {
#pragma unroll
        for (int a = 0; a < 2; ++a)
#pragma unroll
            for (int b = 0; b < 2; ++b)
#pragma unroll
                for (int m = 0; m < 4; ++m)
#pragma unroll
                    for (int n = 0; n < 2; ++n) acc[a][b][m][n] = (f32x4){0.f, 0.f, 0.f, 0.f};
        }
        cur = nxt; cA = nA; cB = nB; ++ui;
        if constexpr (ALIGN_EPI) { if (wr == 1) PG8_BAR; }
    }
    PG8_WAIT_V(0);
    if constexpr (!ALIGN_EPI) { if (wr == 0) PG8_BAR; }
    PG8_BAR;
    if constexpr (Epi::AFTER_DRAIN) E.fused(acc, cur, wr, wc, fr, fq, lds, wid, lane);
#undef PG8_AH
#undef PG8_SA
#undef PG8_SB
#undef PG8_STAGE
#undef PG8_LDA
#undef PG8_LDB
#undef PG8_MMA
#undef PG8_WAIT_V
#undef PG8_WAIT_L
#undef PG8_BAR
#undef PG8_SCHED
}

struct SchedPlain {
    const bf16_t* A; const bf16_t* Bt; int lda, ldb, nM, nN, nt, G, c;
    __device__ __forceinline__ bool next(int i, Unit& u) const {
        const long L = (long)i * G + c; if (L >= (long)nM * nN) return false;
        int pm, pn; order_map((int)L, nM, nN, pm, pn);
        u.a = (const char*)(A + (size_t)pm * BM * lda); u.b = (const char*)(Bt + (size_t)pn * BM * ldb); u.nt = nt; u.pm = pm; u.pn = pn; u.kind = 0; return true;
    }
};
struct SchedIn {
    const bf16_t* XN; const bf16_t* Win; int G, c;
    __device__ __forceinline__ bool next(int i, Unit& u) const {
        const long L = (long)i * G + c;
        if (L < 64 * 22) { int pm, pn; order_map((int)L, 64, 22, pm, pn); pn = pn < 4 ? pn : pn + 2;
            u.a = (const char*)(XN + (size_t)pm * BM * DM); u.b = (const char*)(Win + (size_t)pn * BM * DM); u.nt = 16; u.pm = pm; u.pn = pn; u.kind = 0; return true; }
        if (L < 64 * 22 + 128) { const int j = (int)L - 64 * 22, tn = j >> 1, dm = j & 1;
            u.a = (const char*)(Win + (size_t)(C_V + dm * BM) * DM); u.b = (const char*)(XN + (size_t)tn * BM * DM); u.nt = 16; u.pm = dm; u.pn = tn; u.kind = 1; return true; }
        return false;
    }
};
struct SchedBr {
    const bf16_t* Y; const bf16_t* Wbr; int G, c;
    __device__ __forceinline__ bool next(int i, Unit& u) const {
        const int T = c + (i / 3) * G, seg = i % 3; if (T >= 256) return false;
        int pm, pn; order_map(T, 64, 4, pm, pn);
        const int k0 = seg == 0 ? 0 : (seg == 1 ? 512 : 768);
        u.a = (const char*)(Y + (size_t)pm * BM * DM + k0); u.b = (const char*)(Wbr + (size_t)pn * BM * DM + k0); u.nt = seg == 0 ? 8 : 4; u.pm = pm; u.pn = pn; u.kind = seg; return true;
    }
};

__device__ __forceinline__ void store8(bf16_t* p, f32x4 v0, f32x4 v1) { u32x4 w; w.x = pk2(v0[0], v0[1]); w.y = pk2(v0[2], v0[3]); w.z = pk2(v1[0], v1[1]); w.w = pk2(v1[2], v1[3]); *(u32x4*)p = w; }

struct EpiPlain { static constexpr bool AFTER_DRAIN = false; bf16_t* O; int ldc; const float* rs; static __device__ __forceinline__ bool keep_acc(const Unit&) { return false; }
    __device__ __forceinline__ void operator()(const f32x4 (&acc)[2][2][4][2], const Unit& u, int wr, int wc, int fr, int fq) const {
        const int row0 = u.pm * BM + wr * 64 + fr, col0 = u.pn * BM + wc * 32 + 8 * fq;
        float scv[2][4];
#pragma unroll
        for (int ai = 0; ai < 2; ++ai)
#pragma unroll
            for (int m = 0; m < 4; ++m) scv[ai][m] = rs ? rs[row0 + ai * HALF + m * 16] : 1.f;
#pragma unroll
        for (int ai = 0; ai < 2; ++ai)
#pragma unroll
            for (int m = 0; m < 4; ++m) { const int row = row0 + ai * HALF + m * 16; bf16_t* rowp = O + (size_t)row * ldc + col0; const float sc = scv[ai][m];
#pragma unroll
                for (int bj = 0; bj < 2; ++bj) store8(rowp + bj * HALF, acc[ai][bj][m][0] * sc, acc[ai][bj][m][1] * sc); }
    }
};
struct EpiIn { static constexpr bool AFTER_DRAIN = false; bf16_t* H; bf16_t* Vt; const float* bgate; const float* rs; float* LF; const float* bfg; static __device__ __forceinline__ bool keep_acc(const Unit&) { return false; }
    __device__ __forceinline__ void operator()(const f32x4 (&acc)[2][2][4][2], const Unit& u, int wr, int wc, int fr, int fq) const {
        if (u.kind == 0 && u.pn == 23) {
            if (wc == 0 && fq == 0) {
                const f32x4 bf0 = *(const f32x4*)bfg, bf1 = *(const f32x4*)(bfg + 4);
                float scl[2][4];
#pragma unroll
                for (int ai = 0; ai < 2; ++ai)
#pragma unroll
                    for (int m = 0; m < 4; ++m) scl[ai][m] = rs[u.pm * BM + wr * 64 + fr + ai * HALF + m * 16];
#pragma unroll
                for (int ai = 0; ai < 2; ++ai)
#pragma unroll
                    for (int m = 0; m < 4; ++m) { const int row = u.pm * BM + wr * 64 + fr + ai * HALF + m * 16; const float sc = scl[ai][m]; const int b = row / SEQ, t = row % SEQ;
#pragma unroll
                        for (int e = 0; e < 4; ++e) { const float z0 = acc[ai][0][m][0][e] * sc + bf0[e], z1 = acc[ai][0][m][1][e] * sc + bf1[e];
                            LF[(size_t)(b * 8 + e) * SEQ + t] = fminf(z0, 0.f) - __logf(1.f + __expf(-fabsf(z0)));
                            LF[(size_t)(b * 8 + 4 + e) * SEQ + t] = fminf(z1, 0.f) - __logf(1.f + __expf(-fabsf(z1))); } } }
            return; }
        bf16_t* base; int ld, mode;
        if (u.kind == 1) { base = Vt; ld = M; mode = 4; }
        else { base = H; ld = HW; const int pn = u.pn; mode = pn < 2 ? 1 : ((pn == 9 || pn == 10) ? 2 : (pn >= 11 ? 3 : 0)); }
        const int row0 = u.pm * BM + wr * 64 + fr, col0 = u.pn * BM + wc * 32 + 8 * fq;
        f32x4 bv[2][2];
#pragma unroll
        for (int bj = 0; bj < 2; ++bj)
#pragma unroll
            for (int n = 0; n < 2; ++n) bv[bj][n] = (mode == 3) ? *(const f32x4*)(bgate + (col0 - C_GATE) + bj * HALF + 4 * n) : ((mode == 4) ? *(const f32x4*)(rs + col0 + bj * HALF + 4 * n) : (f32x4){0.f, 0.f, 0.f, 0.f});
        float scv[2][4];
#pragma unroll
        for (int ai = 0; ai < 2; ++ai)
#pragma unroll
            for (int m = 0; m < 4; ++m) scv[ai][m] = (mode == 4) ? 1.f : rs[row0 + ai * HALF + m * 16];
#pragma unroll
        for (int ai = 0; ai < 2; ++ai)
#pragma unroll
            for (int m = 0; m < 4; ++m) { const int row = row0 + ai * HALF + m * 16; bf16_t* rowp = base + (size_t)row * ld + col0;
                const float sc = (mode == 1) ? scv[ai][m] * QSCALE : scv[ai][m];
#pragma unroll
                for (int bj = 0; bj < 2; ++bj) { f32x4 v0 = acc[ai][bj][m][0] * sc, v1 = acc[ai][bj][m][1] * sc;
                    if (mode == 4) { v0 = v0 * bv[bj][0]; v1 = v1 * bv[bj][1]; }
                    else if (mode == 2) {
#pragma unroll
                        for (int e = 0; e < 4; ++e) { v0[e] = gelu_t(v0[e]); v1[e] = gelu_t(v1[e]); } }
                    else if (mode == 3) {
#pragma unroll
                        for (int e = 0; e < 4; ++e) { v0[e] = inv_sigmoid_f(v0[e] + bv[bj][0][e]); v1[e] = inv_sigmoid_f(v1[e] + bv[bj][1][e]); } }
                    store8(rowp + bj * HALF, v0, v1); } }
    }
};
struct EpiBr { static constexpr bool AFTER_DRAIN = false; const bf16_t* H; bf16_t* MG;
    static __device__ __forceinline__ bool keep_acc(const Unit& u) { return u.kind != 2; }
    __device__ __forceinline__ void operator()(f32x4 (&acc)[2][2][4][2], const Unit& u, int wr, int wc, int fr, int fq) const {
        const int seg = u.kind;
        const int row0 = u.pm * BM + wr * 64 + fr, col0 = u.pn * BM + wc * 32 + 8 * fq;
#pragma unroll
        for (int ai = 0; ai < 2; ++ai) {
            u32x4 ga[4][2], gb[4][2];
#pragma unroll
            for (int m = 0; m < 4; ++m)
#pragma unroll
                for (int bj = 0; bj < 2; ++bj) { const bf16_t* gp = H + (size_t)(row0 + ai * HALF + m * 16) * HW + C_GATE + seg * DM + col0 + bj * HALF;
                    ga[m][bj] = *(const u32x4*)gp; gb[m][bj] = (seg < 2) ? *(const u32x4*)(gp + DM) : (u32x4){0u, 0u, 0u, 0u}; }
#pragma unroll
            for (int m = 0; m < 4; ++m)
#pragma unroll
                for (int bj = 0; bj < 2; ++bj) { float g[8]; unpack8(ga[m][bj], g);
#pragma unroll
                    for (int e = 0; e < 8; ++e) g[e] = __builtin_amdgcn_rcpf(g[e]);
                    if (seg < 2) { float h[8]; unpack8(gb[m][bj], h);
#pragma unroll
                        for (int e = 0; e < 8; ++e) g[e] *= h[e];
#pragma unroll
                        for (int e = 0; e < 4; ++e) { acc[ai][bj][m][0][e] *= g[e]; acc[ai][bj][m][1][e] *= g[4 + e]; } }
                    else { f32x4 v0, v1;
#pragma unroll
                        for (int e = 0; e < 4; ++e) { v0[e] = acc[ai][bj][m][0][e] * g[e]; v1[e] = acc[ai][bj][m][1][e] * g[4 + e]; }
                        store8(MG + (size_t)(row0 + ai * HALF + m * 16) * DM + col0 + bj * HALF, v0, v1); } }
        }
    }
};
__device__ __forceinline__ float dpp_shr1(float old, float src) { return __builtin_bit_cast(float, __builtin_amdgcn_update_dpp(__builtin_bit_cast(int, old), __builtin_bit_cast(int, src), 0x111, 0xf, 0xf, false)); }
struct EpiConv { static constexpr bool AFTER_DRAIN = false; bf16_t* ACT; bf16_t* HALO; const float* cw; const float* rs; LAS unsigned char* ex;
    static __device__ __forceinline__ bool keep_acc(const Unit&) { return false; }
    __device__ __forceinline__ void operator()(f32x4 (&acc)[2][2][4][2], const Unit& u, int wr, int wc, int fr, int fq) const {
        const int colA = u.pn * 128 + wc * 32 + 8 * fq;
        const int tok0 = u.pm * BM + 8 * (16 * wr + fr);
        f32x4 cwv[2][3];
#pragma unroll
        for (int n = 0; n < 2; ++n) { const float* wp = cw + colA + 4 * n; cwv[n][0] = *(const f32x4*)wp; cwv[n][1] = *(const f32x4*)(wp + DFF2); cwv[n][2] = *(const f32x4*)(wp + 2 * DFF2); }
        { const f32x4 s0 = *(const f32x4*)(rs + tok0), s1 = *(const f32x4*)(rs + tok0 + 4);
#pragma unroll
          for (int m = 0; m < 4; ++m)
#pragma unroll
            for (int bj = 0; bj < 2; ++bj)
#pragma unroll
                for (int n = 0; n < 2; ++n) { acc[0][bj][m][n] = acc[0][bj][m][n] * s0[m]; acc[1][bj][m][n] = acc[1][bj][m][n] * s1[m]; } }
        LAS float* exw = (LAS float*)ex + (wc * 4 + fq) * 32;
        if (wr == 0 && fr == 15) {
#pragma unroll
            for (int bj = 0; bj < 2; ++bj)
#pragma unroll
                for (int n = 0; n < 2; ++n) { *(LAS f32x4*)(exw + (bj * 2 + n) * 4) = acc[1][bj][2][n]; *(LAS f32x4*)(exw + 16 + (bj * 2 + n) * 4) = acc[1][bj][3][n]; } }
        asm volatile("s_waitcnt lgkmcnt(0)" ::: "memory"); __builtin_amdgcn_s_barrier(); asm volatile("" ::: "memory");
        if (fr == 0 && wr == 0) {
#pragma unroll
            for (int bj = 0; bj < 2; ++bj) { store8(HALO + ((size_t)u.pm * 4 + 0) * DFF2 + bj * DFF + colA, acc[0][bj][0][0], acc[0][bj][0][1]); store8(HALO + ((size_t)u.pm * 4 + 1) * DFF2 + bj * DFF + colA, acc[0][bj][1][0], acc[0][bj][1][1]); } }
        if (fr == 15 && wr == 1) {
#pragma unroll
            for (int bj = 0; bj < 2; ++bj) { store8(HALO + ((size_t)u.pm * 4 + 2) * DFF2 + bj * DFF + colA, acc[1][bj][2][0], acc[1][bj][2][1]); store8(HALO + ((size_t)u.pm * 4 + 3) * DFF2 + bj * DFF + colA, acc[1][bj][3][0], acc[1][bj][3][1]); } }
#pragma unroll
        for (int bj = 0; bj < 2; ++bj)
#pragma unroll
            for (int n = 0; n < 2; ++n) { f32x4 e6 = (f32x4){0.f, 0.f, 0.f, 0.f}, e7 = e6, h2, h1;
                if (wr == 1) { e6 = *(const LAS f32x4*)(exw + (bj * 2 + n) * 4); e7 = *(const LAS f32x4*)(exw + 16 + (bj * 2 + n) * 4); }
#pragma unroll
                for (int e = 0; e < 4; ++e) { h2[e] = dpp_shr1(e6[e], acc[1][bj][2][n][e]); h1[e] = dpp_shr1(e7[e], acc[1][bj][3][n][e]); }
                const float* wp = cw + DFF + colA + 4 * n;
                const f32x4 w0 = bj == 0 ? cwv[n][0] : *(const f32x4*)wp, w1 = bj == 0 ? cwv[n][1] : *(const f32x4*)(wp + DFF2), w2 = bj == 0 ? cwv[n][2] : *(const f32x4*)(wp + 2 * DFF2);
#define XJ(j) acc[(j) >> 2][bj][(j) & 3][n]
                XJ(7) = w2 * XJ(7) + w1 * XJ(6) + w0 * XJ(5); XJ(6) = w2 * XJ(6) + w1 * XJ(5) + w0 * XJ(4); XJ(5) = w2 * XJ(5) + w1 * XJ(4) + w0 * XJ(3);
                XJ(4) = w2 * XJ(4) + w1 * XJ(3) + w0 * XJ(2); XJ(3) = w2 * XJ(3) + w1 * XJ(2) + w0 * XJ(1); XJ(2) = w2 * XJ(2) + w1 * XJ(1) + w0 * XJ(0);
                XJ(1) = w2 * XJ(1) + w1 * XJ(0) + w0 * h1; XJ(0) = w2 * XJ(0) + w1 * h1 + w0 * h2;
#undef XJ
            }
#pragma unroll
        for (int ai = 0; ai < 2; ++ai)
#pragma unroll
            for (int m = 0; m < 4; ++m) { f32x4 v0, v1;
#pragma unroll
                for (int e = 0; e < 4; ++e) { v0[e] = gelu_t(acc[ai][0][m][0][e]) * acc[ai][1][m][0][e]; v1[e] = gelu_t(acc[ai][0][m][1][e]) * acc[ai][1][m][1][e]; }
                store8(ACT + (size_t)(tok0 + 4 * ai + m) * DFF + colA, v0, v1); }
    }
};
struct PanelSum { float* X; unsigned* cnt; };
__device__ __forceinline__ void panel_sum(const PanelSum& ps, float (&v)[8], const Unit& u, int wr, int wc, int fr, int fq, LAS unsigned char* lds, int wid, int lane) {
    LAS float* P = (LAS float*)lds; LAS float* S = (LAS float*)(lds + 4096);
#pragma unroll
    for (int sl = 0; sl < 8; ++sl) { v[sl] += __shfl_xor(v[sl], 16); v[sl] += __shfl_xor(v[sl], 32); }
    if (fq == 0) {
#pragma unroll
        for (int sl = 0; sl < 8; ++sl) P[(128 * (sl >> 2) + 64 * wr + 16 * (sl & 3) + fr) * 4 + wc] = v[sl]; }
    __syncthreads();
    const int tid = wid * 64 + lane;
    if (tid < 256) { const float s = (P[tid * 4 + 0] + P[tid * 4 + 1]) + (P[tid * 4 + 2] + P[tid * 4 + 3]);
        __hip_atomic_store(ps.X + ((size_t)u.pm * 256 + tid) * 4 + u.pn, s, __ATOMIC_RELAXED, __HIP_MEMORY_SCOPE_AGENT); }
    asm volatile("s_waitcnt vmcnt(0)" ::: "memory");
    if (tid < 256 && lane == 0) __hip_atomic_fetch_add(ps.cnt + 64 * u.pm, 1u, __ATOMIC_RELAXED, __HIP_MEMORY_SCOPE_AGENT);
    if (wid == 0) { unsigned sp = 0;
        while ((unsigned)__builtin_amdgcn_readfirstlane(__hip_atomic_load(ps.cnt + 64 * u.pm, __ATOMIC_RELAXED, __HIP_MEMORY_SCOPE_AGENT)) < 16u) { __builtin_amdgcn_s_sleep(2); if (++sp > (1u << 22)) break; }
        __builtin_amdgcn_fence(__ATOMIC_ACQUIRE, "agent"); }
    asm volatile("s_waitcnt vmcnt(0) lgkmcnt(0)" ::: "memory");
    __syncthreads();
    if (tid < 256) { const float* xp = ps.X + ((size_t)u.pm * 256 + tid) * 4; float t = 0.f;
#pragma unroll
        for (int k = 0; k < 4; ++k) t += __hip_atomic_load(xp + k, __ATOMIC_RELAXED, __HIP_MEMORY_SCOPE_AGENT);
        S[tid] = t; }
    __syncthreads();
#pragma unroll
    for (int sl = 0; sl < 8; ++sl) v[sl] = S[128 * (sl >> 2) + 64 * wr + 16 * (sl & 3) + fr];
}
template <bool X_F32, bool FINAL> struct EpiResNorm {
    static constexpr bool AFTER_DRAIN = true;
    static __device__ __forceinline__ bool keep_acc(const Unit&) { return false; }
    const float* x32; bf16_t* XB; const float* gpost; float* RS; float* out; PanelSum s1, s2;
    __device__ __forceinline__ void operator()(f32x4 (&)[2][2][4][2], const Unit&, int, int, int, int) const {}
    __device__ __forceinline__ void fused(f32x4 (&acc)[2][2][4][2], const Unit& u, int wr, int wc, int fr, int fq, LAS unsigned char* lds, int wid, int lane) const {
        const int row0 = u.pm * BM + wr * 64 + fr, col0 = u.pn * BM + wc * 32 + 8 * fq;
        float v[8];
#pragma unroll
        for (int sl = 0; sl < 8; ++sl) { const int ai = sl >> 2, m = sl & 3; float s = 0.f;
#pragma unroll
            for (int bj = 0; bj < 2; ++bj)
#pragma unroll
                for (int n = 0; n < 2; ++n) { const f32x4 a = acc[ai][bj][m][n]; s += (a[0] * a[0] + a[1] * a[1]) + (a[2] * a[2] + a[3] * a[3]); }
            v[sl] = s; }
        u32x4 xr[4][2]; f32x4 g[2][2];
#pragma unroll
        for (int bj = 0; bj < 2; ++bj)
#pragma unroll
            for (int n = 0; n < 2; ++n) g[bj][n] = *(const f32x4*)(gpost + col0 + bj * HALF + 4 * n);
        if (!X_F32) {
#pragma unroll
            for (int sl = 0; sl < 4; ++sl)
#pragma unroll
                for (int bj = 0; bj < 2; ++bj) xr[sl][bj] = *(const u32x4*)(XB + (size_t)(row0 + sl * 16) * DM + col0 + bj * HALF); }
        panel_sum(s1, v, u, wr, wc, fr, fq, lds, wid, lane);
#pragma unroll
        for (int sl = 0; sl < 8; ++sl) { const int ai = sl >> 2, m = sl & 3; const size_t row = (size_t)(row0 + ai * HALF + m * 16);
            const float ry = __builtin_amdgcn_rsqf(v[sl] * (1.f / DM) + 1e-6f);
#pragma unroll
            for (int bj = 0; bj < 2; ++bj) { f32x4 x0, x1;
                if (X_F32) { x0 = *(const f32x4*)(x32 + row * DM + col0 + bj * HALF); x1 = *(const f32x4*)(x32 + row * DM + col0 + bj * HALF + 4); }
                else { float xf[8]; unpack8(sl < 4 ? xr[sl & 3][bj] : *(const u32x4*)(XB + row * DM + col0 + bj * HALF), xf); x0 = (f32x4){xf[0], xf[1], xf[2], xf[3]}; x1 = (f32x4){xf[4], xf[5], xf[6], xf[7]}; }
                acc[ai][bj][m][0] = x0 + acc[ai][bj][m][0] * ry * g[bj][0]; acc[ai][bj][m][1] = x1 + acc[ai][bj][m][1] * ry * g[bj][1]; } }
        if (FINAL) {
#pragma unroll
            for (int sl = 0; sl < 8; ++sl) { const int ai = sl >> 2, m = sl & 3; float* op = out + (size_t)(row0 + ai * HALF + m * 16) * DM + col0;
#pragma unroll
                for (int bj = 0; bj < 2; ++bj) { *(f32x4*)(op + bj * HALF) = acc[ai][bj][m][0]; *(f32x4*)(op + bj * HALF + 4) = acc[ai][bj][m][1]; } }
            return; }
#pragma unroll
        for (int sl = 0; sl < 8; ++sl) { const int ai = sl >> 2, m = sl & 3; float s = 0.f;
#pragma unroll
            for (int bj = 0; bj < 2; ++bj)
#pragma unroll
                for (int n = 0; n < 2; ++n) { const f32x4 a = acc[ai][bj][m][n]; s += (a[0] * a[0] + a[1] * a[1]) + (a[2] * a[2] + a[3] * a[3]); }
            v[sl] = s; }
        panel_sum(s2, v, u, wr, wc, fr, fq, lds, wid, lane);
#pragma unroll
        for (int sl = 0; sl < 8; ++sl) { const int ai = sl >> 2, m = sl & 3; const size_t row = (size_t)(row0 + ai * HALF + m * 16);
            if (u.pn == 0 && wc == 0 && fq == 0) RS[row] = __builtin_amdgcn_rsqf(v[sl] * (1.f / DM) + 1e-6f);
#pragma unroll
            for (int bj = 0; bj < 2; ++bj) store8(XB + row * DM + col0 + bj * HALF, acc[ai][bj][m][0], acc[ai][bj][m][1]); }
    }
};
}

struct Params { const float* in[20]; float* out; unsigned char* ws; };
enum { I_X = 0, I_PRE_MIX_G, I_POST_MIX_G, I_PRE_FFN_G, I_POST_FFN_G, I_W_IN, I_B_FORGET, I_B_GATE, I_CONV_MIX_W, I_SGU_LN_G, I_SGU_LN_B, I_SGU_W, I_SGU_B,
       I_W_BR_ATT, I_W_BR_CONV, I_W_BR_SGU, I_W_OUT, I_W_FFN_UP, I_CONV_FFN_W, I_W_FFN_DOWN };

__device__ __forceinline__ void tr_item(const float* W, int ldw, int srccol0, int k0, const float* gk, bf16_t* WT, int ldt, int dstrow0, int dstk0, LAS float* scr, int lane) {
    f32x4 v[8];
#pragma unroll
    for (int i = 0; i < 8; ++i) { const int kk = (lane >> 3) + 8 * i; v[i] = __builtin_nontemporal_load((const f32x4*)(W + (size_t)(k0 + kk) * ldw + srccol0 + 4 * (lane & 7))); }
#pragma unroll
    for (int i = 0; i < 8; ++i) { const int kk = (lane >> 3) + 8 * i; const float g = gk ? gk[k0 + kk] : 1.f; LAS float* d = scr + kk * 33 + 4 * (lane & 7);
        d[0] = v[i][0] * g; d[1] = v[i][1] * g; d[2] = v[i][2] * g; d[3] = v[i][3] * g; }
    asm volatile("s_waitcnt lgkmcnt(0)" ::: "memory");
    const int c = lane & 7;
#pragma unroll
    for (int j = 0; j < 4; ++j) { const int n = (lane >> 3) + 8 * j; const LAS float* s = scr + (8 * c) * 33 + n;
        u32x4 o; o.x = pk2(s[0 * 33], s[1 * 33]); o.y = pk2(s[2 * 33], s[3 * 33]); o.z = pk2(s[4 * 33], s[5 * 33]); o.w = pk2(s[6 * 33], s[7 * 33]);
        *(u32x4*)(WT + (size_t)(dstrow0 + n) * ldt + dstk0 + 8 * c) = o; }
    asm volatile("s_waitcnt lgkmcnt(0)" ::: "memory");
}
template <int PARTS>
__device__ __forceinline__ void convert_weights(const Params& p, int l, LAS unsigned char* lds, int gw, int NGW, int lane, int wave) {
    unsigned char* ws = p.ws;
    LAS float* scr = (LAS float*)(lds + 32768 + wave * 8448);
    const size_t ffo = (l & 1) ? (WS_FFN2 - WS_WUP) : 0;
    bf16_t* Win = (bf16_t*)(ws + WS_WIN); bf16_t* Wbr = (bf16_t*)(ws + WS_WBR); bf16_t* Wout = (bf16_t*)(ws + WS_WOUT); bf16_t* Wup = (bf16_t*)(ws + WS_WUP + ffo); bf16_t* Wdn = (bf16_t*)(ws + WS_WDN + ffo);
    constexpr int N_IN = 16 * 184, N_BA = 8 * 32, N_BC = 4 * 32, N_BS = 4 * 32, N_OUT = 16 * 32, N_UP = 16 * 176, N_DN = 44 * 32;
    if constexpr ((PARTS & 1) != 0) {
        const float* w_in = p.in[I_W_IN] + (size_t)l * DM * INW; const float* g1 = p.in[I_PRE_MIX_G] + l * DM;
        for (int r = gw; r < N_IN; r += NGW) { const int kb = r / 184, nb = r % 184, n0 = nb * 32; tr_item(w_in, INW, n0 + (n0 >= 1536 ? 8 : 0), kb * 64, g1, Win, DM, n0, kb * 64, scr, lane); }
        for (int e = gw * 64 + lane; e < 256 * DM / 2; e += NGW * 64) { const int idx = 2 * e, hrow = idx >> 10, k = idx & 1023;
            float a = 0.f, b = 0.f; if (hrow < 8) { a = g1[k] * w_in[(size_t)k * INW + 1536 + hrow]; b = g1[k + 1] * w_in[(size_t)(k + 1) * INW + 1536 + hrow]; }
            *(unsigned*)(Win + (size_t)5888 * DM + idx) = pk2(a, b); }
    }
    if constexpr ((PARTS & 2) != 0) {
        const float* w_out = p.in[I_W_OUT] + (size_t)l * DM * DM;
        const float* w_ba = p.in[I_W_BR_ATT] + (size_t)l * 512 * DM; const float* w_bc = p.in[I_W_BR_CONV] + (size_t)l * 256 * DM; const float* w_bs = p.in[I_W_BR_SGU] + (size_t)l * 256 * DM;
        for (int it = gw; it < N_BA + N_BC + N_BS + N_OUT; it += NGW) { int r = it;
            if (r < N_BA) { const int kb = r / 32, nb = r % 32; tr_item(w_ba, DM, nb * 32, kb * 64, nullptr, Wbr, DM, nb * 32, kb * 64, scr, lane); continue; } r -= N_BA;
            if (r < N_BC) { const int kb = r / 32, nb = r % 32; tr_item(w_bc, DM, nb * 32, kb * 64, nullptr, Wbr, DM, nb * 32, 512 + kb * 64, scr, lane); continue; } r -= N_BC;
            if (r < N_BS) { const int kb = r / 32, nb = r % 32; tr_item(w_bs, DM, nb * 32, kb * 64, nullptr, Wbr, DM, nb * 32, 768 + kb * 64, scr, lane); continue; } r -= N_BS;
            { const int kb = r / 32, nb = r % 32; tr_item(w_out, DM, nb * 32, kb * 64, nullptr, Wout, DM, nb * 32, kb * 64, scr, lane); } }
    }
    if constexpr ((PARTS & 4) != 0) {
        const float* w_up = p.in[I_W_FFN_UP] + (size_t)l * DM * DFF2; const float* w_dn = p.in[I_W_FFN_DOWN] + (size_t)l * DFF * DM; const float* g3 = p.in[I_PRE_FFN_G] + l * DM;
        for (int it = gw; it < N_UP + N_DN; it += NGW) { int r = it;
            if (r < N_UP) { const int kb = r / 176, nb = r % 176, n0 = nb * 32, nh = n0 < DFF ? n0 : n0 - DFF; const int drow = (nh >> 7) * 256 + (n0 < DFF ? 0 : 128) + (nh & 127);
                tr_item(w_up, DFF2, n0, kb * 64, g3, Wup, DM, drow, kb * 64, scr, lane); continue; } r -= N_UP;
            { const int kb = r / 32, nb = r % 32; tr_item(w_dn, DM, nb * 32, kb * 64, nullptr, Wdn, DFF, nb * 32, kb * 64, scr, lane); } }
        const float* sw = p.in[I_SGU_W] + (size_t)l * 4 * 128 * 128; bf16_t* Wm = (bf16_t*)(ws + WS_WM + ffo);
        for (int e = gw * 64 + lane; e < 4 * 128 * 128 / 2; e += NGW * 64) { const int idx = 2 * e, t = (idx >> 7) & 127, s = idx & 127;
            const float a = s <= t ? sw[idx] : 0.f, b = (s + 1) <= t ? sw[idx + 1] : 0.f; *(unsigned*)(Wm + idx) = pk2(a, b); }
    }
}

template <bool X_F32, bool HAS_Y, bool WR_XB, bool WR_LF, bool WR_OUT, int R = 4>
__device__ __forceinline__ void row_phase(const float* x32, const bf16_t* y, const float* gpost, bf16_t* XB, float* RS, float* out, LAS const float* wfl, const float* bfg, float* LF, int gw, int NGW, int lane) {
    for (int row0 = gw; row0 < M; row0 += R * NGW) {
        f32x4 v[R][4]; f32x4 yy[R][4]; bool ok[R]; float r[R];
#pragma unroll
        for (int u = 0; u < R; ++u) { const int row = row0 + u * NGW; ok[u] = row < M; const int rr = ok[u] ? row : row0;
#pragma unroll
            for (int j = 0; j < 4; ++j) {
                if (X_F32) v[u][j] = __builtin_nontemporal_load((const f32x4*)(x32 + (size_t)rr * DM + 256 * j + 4 * lane));
                else { const u32x2 w = *(const u32x2*)(XB + (size_t)rr * DM + 256 * j + 4 * lane); v[u][j] = (f32x4){bflo(w.x), bfhi(w.x), bflo(w.y), bfhi(w.y)}; } }
            if (HAS_Y) {
#pragma unroll
                for (int j = 0; j < 4; ++j) { const u32x2 w = *(const u32x2*)(y + (size_t)rr * DM + 256 * j + 4 * lane); yy[u][j] = (f32x4){bflo(w.x), bfhi(w.x), bflo(w.y), bfhi(w.y)}; } } }
        if (HAS_Y) {
#pragma unroll
            for (int u = 0; u < R; ++u) { const int row = row0 + u * NGW; float ss = 0.f;
#pragma unroll
                for (int j = 0; j < 4; ++j) ss += (yy[u][j][0] * yy[u][j][0] + yy[u][j][1] * yy[u][j][1]) + (yy[u][j][2] * yy[u][j][2] + yy[u][j][3] * yy[u][j][3]);
                ss = wave_sum(ss); const float ry = __builtin_amdgcn_rsqf(ss * (1.f / DM) + 1e-6f);
#pragma unroll
                for (int j = 0; j < 4; ++j) { const f32x4 g = *(const f32x4*)(gpost + 256 * j + 4 * lane); v[u][j] = v[u][j] + yy[u][j] * ry * g;
                    if (WR_OUT && ok[u]) *(f32x4*)(out + (size_t)row * DM + 256 * j + 4 * lane) = v[u][j]; } }
        }
        if (WR_XB) {
#pragma unroll
            for (int u = 0; u < R; ++u) { const int row = row0 + u * NGW; float s2 = 0.f;
#pragma unroll
                for (int j = 0; j < 4; ++j) s2 += (v[u][j][0] * v[u][j][0] + v[u][j][1] * v[u][j][1]) + (v[u][j][2] * v[u][j][2] + v[u][j][3] * v[u][j][3]);
                s2 = wave_sum(s2); r[u] = __builtin_amdgcn_rsqf(s2 * (1.f / DM) + 1e-6f);
                if (ok[u]) { if (lane == 0) RS[row] = r[u];
#pragma unroll
                    for (int j = 0; j < 4; ++j) { u32x2 w; w.x = pk2(v[u][j][0], v[u][j][1]); w.y = pk2(v[u][j][2], v[u][j][3]); *(u32x2*)(XB + (size_t)row * DM + 256 * j + 4 * lane) = w; } } }
            if (WR_LF) {
                float mine[R];
#pragma unroll
                for (int u = 0; u < R; ++u) mine[u] = 0.f;
#pragma unroll
                for (int h = 0; h < 8; ++h) { float pa[R];
#pragma unroll
                    for (int u = 0; u < R; ++u) pa[u] = 0.f;
#pragma unroll
                    for (int j = 0; j < 4; ++j) { const f32x4 w = *(const LAS f32x4*)(wfl + h * DM + 256 * j + 4 * lane);
#pragma unroll
                        for (int u = 0; u < R; ++u) pa[u] += (v[u][j][0] * w[0] + v[u][j][1] * w[1]) + (v[u][j][2] * w[2] + v[u][j][3] * w[3]); }
#pragma unroll
                    for (int u = 0; u < R; ++u) { pa[u] = wave_sum(pa[u]); if (lane == h) mine[u] = pa[u]; } }
#pragma unroll
                for (int u = 0; u < R; ++u) { const int row = row0 + u * NGW;
                    if (lane < 8 && ok[u]) { const float z = mine[u] * r[u] + bfg[lane]; const float lf = fminf(z, 0.f) - __logf(1.f + __expf(-fabsf(z)));
                        const int b = row / SEQ, t = row % SEQ; LF[(size_t)(b * 8 + lane) * SEQ + t] = lf; } }
            }
        }
    }
}
template <bool TO_LDS> __device__ __forceinline__ void build_wf(const Params& p, int l, LAS float* wfl, float* wfg) {
    const float* w_in = p.in[I_W_IN] + (size_t)l * DM * INW; const float* g1 = p.in[I_PRE_MIX_G] + l * DM;
    const int t0 = ltid(); float vals[16];
#pragma unroll
    for (int i = 0; i < 16; ++i) { const int idx = t0 + 512 * i, k = idx >> 3, h = idx & 7; vals[i] = g1[k] * w_in[(size_t)k * INW + 1536 + h]; }
#pragma unroll
    for (int i = 0; i < 16; ++i) { const int idx = t0 + 512 * i, k = idx >> 3, h = idx & 7; if (TO_LDS) wfl[h * DM + k] = vals[i]; else wfg[h * DM + k] = vals[i]; }
    __syncthreads();
}
__device__ __forceinline__ void load_wf(const float* wfg, LAS float* wfl) {
    const int t0 = ltid();
#pragma unroll
    for (int i = 0; i < 4; ++i) *(LAS f32x4*)(wfl + 4 * (t0 + 512 * i)) = *(const f32x4*)(wfg + 4 * (t0 + 512 * i));
    __syncthreads();
}

__device__ __forceinline__ float max3f(float a, float b, float c) { float r; asm("v_max3_f32 %0, %1, %2, %3" : "=v"(r) : "v"(a), "v"(b), "v"(c)); return r; }
constexpr int A_K = 0, A_KBUF = 64 * 144, A_V = 2 * A_KBUF, A_VBUF = 64 * 136, A_CS = 36864, A_WS = A_CS + 16384, A_KX = A_WS + 256;
__device__ __forceinline__ void attn_unit(LAS unsigned char* lds, const bf16_t* __restrict__ H, const bf16_t* __restrict__ Vt, const float* __restrict__ LF, bf16_t* __restrict__ Y, int b, int h, int qb, bool do_scan) {
    const int tid = ltid(), lane = tid & 63, wid = __builtin_amdgcn_readfirstlane(tid >> 6), r32 = lane & 31, hi = lane >> 5;
    const int q0 = qb * 256, NT = (q0 + 256) / 64;
    LAS float* cs = (LAS float*)(lds + A_CS); LAS float* wsum = (LAS float*)(lds + A_WS);
    const size_t rowbase = (size_t)b * SEQ;
    const bf16_t* kg = H + (rowbase + (tid >> 3)) * HW + C_K + h * 64 + (tid & 7) * 8;
    const bf16_t* vg = Vt + (size_t)(h * 64 + (tid >> 3)) * M + rowbase + (tid & 7) * 8;
    const int kw = (tid >> 3) * 144 + (tid & 7) * 16, vw = (tid >> 3) * 136 + (tid & 7) * 16;
    u32x4 kreg = *(const u32x4*)kg, vreg = *(const u32x4*)vg;
    u32x4 kreg2 = *(const u32x4*)(kg + (size_t)64 * HW), vreg2 = *(const u32x4*)(vg + 64);
    const int qpos = q0 + wid * 32 + r32;
    const bf16_t* qg = H + (rowbase + qpos) * HW + C_Q + h * 64 + hi * 8;
    bf16x8 qr[4];
#pragma unroll
    for (int ds = 0; ds < 4; ++ds) qr[ds] = *(const bf16x8*)(qg + ds * 16);
    if (do_scan) {
        const float* lf = LF + (size_t)(b * 8 + h) * SEQ + tid * 8;
        const f32x4 a0 = *(const f32x4*)lf, a1 = *(const f32x4*)(lf + 4);
        float v[8] = {a0[0], a0[1], a0[2], a0[3], a1[0], a1[1], a1[2], a1[3]};
#pragma unroll
        for (int j = 1; j < 8; ++j) v[j] += v[j - 1];
        const float tot = v[7]; float s = tot;
#pragma unroll
        for (int o = 1; o < 64; o <<= 1) { const float t = __shfl_up(s, o); if (lane >= o) s += t; }
        if (lane == 63) wsum[wid] = s;
        __syncthreads();
        float off = s - tot;
        for (int w = 0; w < wid; ++w) off += wsum[w];
        f32x4 c0, c1;
#pragma unroll
        for (int j = 0; j < 4; ++j) { c0[j] = (off + v[j]) * LOG2E; c1[j] = (off + v[4 + j]) * LOG2E; }
        *(LAS f32x4*)(cs + tid * 8) = c0; *(LAS f32x4*)(cs + tid * 8 + 4) = c1;
    }
    *(LAS u32x4*)(lds + A_K + kw) = kreg;
    *(LAS u32x2*)(lds + A_V + vw) = (u32x2){vreg.x, vreg.y}; *(LAS u32x2*)(lds + A_V + vw + 8) = (u32x2){vreg.z, vreg.w};
    __syncthreads();
    const float cref = cs[q0 + 255];
    const float cqr = cs[qpos] - cref;
    const unsigned ONES = hi ? 0u : 0x3F803F80u;
    LAS unsigned* kxw = (LAS unsigned*)(lds + A_KX);
    if (tid * 8 < NT * 64) { const f32x4 ca = *(const LAS f32x4*)(cs + tid * 8), cb = *(const LAS f32x4*)(cs + tid * 8 + 4); unsigned wv[8];
#pragma unroll
        for (int j = 0; j < 8; ++j) { const float b_ = (j < 4 ? ca[j & 3] : cb[j & 3]) - cref; const unsigned h_ = pk2(b_, 0.f) & 0xffffu; const float l_ = b_ - bflo(h_); wv[j] = (h_ | (pk2(l_, 0.f) << 16)) ^ 0x80008000u; }
        *(LAS u32x4*)(kxw + tid * 8) = (u32x4){wv[0], wv[1], wv[2], wv[3]}; *(LAS u32x4*)(kxw + tid * 8 + 4) = (u32x4){wv[4], wv[5], wv[6], wv[7]}; }
    __syncthreads();
    bf16x8 qx;
#define ATT_QX() do { const float a_ = cqr - mrun; const unsigned h_ = pk2(a_, 0.f) & 0xffffu; const float l_ = a_ - bflo(h_); \
        const unsigned w_ = hi ? 0u : (h_ | (pk2(l_, 0.f) << 16)); qx = __builtin_bit_cast(bf16x8, (u32x4){w_, ONES, 0u, 0u}); } while (0)
    f32x16 o0, o1;
#pragma unroll
    for (int r = 0; r < 16; ++r) { o0[r] = 0.f; o1[r] = 0.f; }
    float mrun = 0.f, lrun = 0.f;
    ATT_QX();
    const int wlim = (32 * wid + 31) >> 6;
    for (int t = 0; t < NT; ++t) {
        const int buf = t & 1;
        kreg = kreg2; vreg = vreg2;
        if (t + 2 < NT) { kreg2 = *(const u32x4*)(kg + (size_t)(t + 2) * 64 * HW); vreg2 = *(const u32x4*)(vg + (t + 2) * 64); }
        const int jb = t - (NT - 4);
        if (jb <= wlim) {
        const LAS unsigned char* kb = lds + A_K + buf * A_KBUF + r32 * 144 + hi * 16;
        const LAS unsigned char* vb = lds + A_V + buf * A_VBUF + r32 * 136 + hi * 8;
        bf16x8 kf0[4], kf1[4];
#pragma unroll
        for (int ds = 0; ds < 4; ++ds) { kf0[ds] = *(const LAS bf16x8*)(kb + ds * 32); kf1[ds] = *(const LAS bf16x8*)(kb + 32 * 144 + ds * 32); }
        f32x16 p0, p1;
#pragma unroll
        for (int r = 0; r < 16; ++r) { p0[r] = 0.f; p1[r] = 0.f; }
        bf16x8 kx0, kx1;
        { const unsigned w0 = hi ? 0u : kxw[t * 64 + r32], w1 = hi ? 0u : kxw[t * 64 + 32 + r32];
          kx0 = __builtin_bit_cast(bf16x8, (u32x4){ONES, w0, 0u, 0u}); kx1 = __builtin_bit_cast(bf16x8, (u32x4){ONES, w1, 0u, 0u}); }
        u32x2 vl0[4], vh0[4], vl1[4], vh1[4];
#pragma unroll
        for (int j = 0; j < 4; ++j) { vl0[j] = *(const LAS u32x2*)(vb + j * 32); vh0[j] = *(const LAS u32x2*)(vb + j * 32 + 16);
            vl1[j] = *(const LAS u32x2*)(vb + 32 * 136 + j * 32); vh1[j] = *(const LAS u32x2*)(vb + 32 * 136 + j * 32 + 16); }
        __builtin_amdgcn_s_setprio(1);
        p0 = __builtin_amdgcn_mfma_f32_32x32x16_bf16(kx0, qx, p0, 0, 0, 0); p1 = __builtin_amdgcn_mfma_f32_32x32x16_bf16(kx1, qx, p1, 0, 0, 0);
#pragma unroll
        for (int ds = 0; ds < 4; ++ds) { p0 = __builtin_amdgcn_mfma_f32_32x32x16_bf16(kf0[ds], qr[ds], p0, 0, 0, 0); p1 = __builtin_amdgcn_mfma_f32_32x32x16_bf16(kf1[ds], qr[ds], p1, 0, 0, 0); }
        __builtin_amdgcn_s_setprio(0);
        if (jb >= 0) { const int thr = qpos - (t * 64 + 4 * hi);
#pragma unroll
            for (int rg = 0; rg < 4; ++rg)
#pragma unroll
                for (int i = 0; i < 4; ++i) { if (8 * rg + i > thr) p0[4 * rg + i] = -INFINITY; if (8 * rg + i + 32 > thr) p1[4 * rg + i] = -INFINITY; } }
        float rm = fmaxf(p1[14], p1[15]);
#pragma unroll
        for (int r = 0; r < 14; ++r) rm = max3f(rm, p0[r], p1[r]);
        rm = max3f(rm, p0[14], p0[15]);
        { auto rr = __builtin_amdgcn_permlane32_swap(__builtin_bit_cast(unsigned, rm), __builtin_bit_cast(unsigned, rm), false, false);
          rm = fmaxf(__builtin_bit_cast(float, rr[0]), __builtin_bit_cast(float, rr[1])); }
        if (__any(rm > 8.f)) { const float dl = fmaxf(rm, 0.f); mrun += dl; const float f = __builtin_amdgcn_exp2f(-dl); lrun *= f;
#pragma unroll
            for (int r = 0; r < 16; ++r) { p0[r] -= dl; p1[r] -= dl; o0[r] *= f; o1[r] *= f; }
            ATT_QX(); }
        float ps0 = 0.f, ps1 = 0.f;
#pragma unroll
        for (int r = 0; r < 16; ++r) { p0[r] = __builtin_amdgcn_exp2f(p0[r]); p1[r] = __builtin_amdgcn_exp2f(p1[r]); ps0 += p0[r]; ps1 += p1[r]; }
        lrun += ps0 + ps1;
        bf16x8 pa[4];
        { u32x4 w;
          w.x = pk2(p0[0], p0[1]); w.y = pk2(p0[2], p0[3]); w.z = pk2(p0[4], p0[5]); w.w = pk2(p0[6], p0[7]); pa[0] = __builtin_bit_cast(bf16x8, w);
          w.x = pk2(p0[8], p0[9]); w.y = pk2(p0[10], p0[11]); w.z = pk2(p0[12], p0[13]); w.w = pk2(p0[14], p0[15]); pa[1] = __builtin_bit_cast(bf16x8, w);
          w.x = pk2(p1[0], p1[1]); w.y = pk2(p1[2], p1[3]); w.z = pk2(p1[4], p1[5]); w.w = pk2(p1[6], p1[7]); pa[2] = __builtin_bit_cast(bf16x8, w);
          w.x = pk2(p1[8], p1[9]); w.y = pk2(p1[10], p1[11]); w.z = pk2(p1[12], p1[13]); w.w = pk2(p1[14], p1[15]); pa[3] = __builtin_bit_cast(bf16x8, w); }
#pragma unroll
        for (int j = 0; j < 4; ++j) {
            const bf16x8 vf0 = __builtin_bit_cast(bf16x8, (u32x4){vl0[j].x, vl0[j].y, vh0[j].x, vh0[j].y}), vf1 = __builtin_bit_cast(bf16x8, (u32x4){vl1[j].x, vl1[j].y, vh1[j].x, vh1[j].y});
            o0 = __builtin_amdgcn_mfma_f32_32x32x16_bf16(vf0, pa[j], o0, 0, 0, 0); o1 = __builtin_amdgcn_mfma_f32_32x32x16_bf16(vf1, pa[j], o1, 0, 0, 0); }
        }
        if (t + 1 < NT) { const int nb = buf ^ 1;
            *(LAS u32x4*)(lds + A_K + nb * A_KBUF + kw) = kreg;
            *(LAS u32x2*)(lds + A_V + nb * A_VBUF + vw) = (u32x2){vreg.x, vreg.y}; *(LAS u32x2*)(lds + A_V + nb * A_VBUF + vw + 8) = (u32x2){vreg.z, vreg.w}; }
        __syncthreads();
    }
#undef ATT_QX
    lrun += __shfl_xor(lrun, 32);
    const float inv = 1.f / lrun;
    bf16_t* yp = Y + (rowbase + qpos) * DM + h * 64 + 4 * hi;
#pragma unroll
    for (int rg = 0; rg < 4; ++rg) {
        u32x2 w0, w1; w0.x = pk2(o0[4 * rg] * inv, o0[4 * rg + 1] * inv); w0.y = pk2(o0[4 * rg + 2] * inv, o0[4 * rg + 3] * inv);
        w1.x = pk2(o1[4 * rg] * inv, o1[4 * rg + 1] * inv); w1.y = pk2(o1[4 * rg + 2] * inv, o1[4 * rg + 3] * inv);
        *(u32x2*)(yp + 8 * rg) = w0; *(u32x2*)(yp + 32 + 8 * rg) = w1; }
}

__device__ __forceinline__ void sgu_unit(LAS unsigned char* lds, const Params& p, int l, const bf16_t* __restrict__ H, const bf16_t* __restrict__ Wm, bf16_t* __restrict__ Y, int unit) {
    const int tid = ltid(), lane = tid & 63, wid = __builtin_amdgcn_readfirstlane(tid >> 6), r32 = lane & 31, hi = lane >> 5;
    const size_t rowbase = (size_t)unit * 128;
    const float* lng = p.in[I_SGU_LN_G] + l * 256; const float* lnb = p.in[I_SGU_LN_B] + l * 256; const float* sb = p.in[I_SGU_B] + l * 512;
    LAS bf16_t* VT = (LAS bf16_t*)lds;
    const f32x4 g4 = *(const f32x4*)(lng + 4 * lane), b4 = *(const f32x4*)(lnb + 4 * lane);
    {
        u32x2 w[16];
#pragma unroll
        for (int i = 0; i < 16; ++i) w[i] = *(const u32x2*)(H + (rowbase + wid * 16 + i) * HW + C_VS + 4 * lane);
        f32x4 v[16]; float mu[16], var[16];
#pragma unroll
        for (int i = 0; i < 16; ++i) { v[i] = (f32x4){bflo(w[i].x), bfhi(w[i].x), bflo(w[i].y), bfhi(w[i].y)}; mu[i] = (v[i][0] + v[i][1]) + (v[i][2] + v[i][3]); }
#pragma unroll
        for (int i = 0; i < 16; ++i) mu[i] = wave_sum(mu[i]) * (1.f / 256.f);
#pragma unroll
        for (int i = 0; i < 16; ++i) { v[i] = v[i] - mu[i]; var[i] = (v[i][0] * v[i][0] + v[i][1] * v[i][1]) + (v[i][2] * v[i][2] + v[i][3] * v[i][3]); }
#pragma unroll
        for (int i = 0; i < 16; ++i) var[i] = wave_sum(var[i]) * (1.f / 256.f);
#pragma unroll
        for (int i = 0; i < 16; ++i) { const float rs = __builtin_amdgcn_rsqf(var[i] + 1e-5f); v[i] = v[i] * rs * g4 + b4; }
#pragma unroll
        for (int e = 0; e < 4; ++e) { u32x4 w0, w1;
            w0.x = pk2(v[0][e], v[1][e]); w0.y = pk2(v[2][e], v[3][e]); w0.z = pk2(v[4][e], v[5][e]); w0.w = pk2(v[6][e], v[7][e]);
            w1.x = pk2(v[8][e], v[9][e]); w1.y = pk2(v[10][e], v[11][e]); w1.z = pk2(v[12][e], v[13][e]); w1.w = pk2(v[14][e], v[15][e]);
            LAS u32x4* dst = (LAS u32x4*)(VT + (4 * lane + e) * 136 + wid * 16); dst[0] = w0; dst[1] = w1; }
    }
    __syncthreads();
    const int g = wid >> 1, db = wid & 1;
    const LAS unsigned char* ab = lds + ((g * 64 + db * 32 + r32) * 136 + hi * 8) * 2;
    bf16x8 bfr[4][8]; u32x2 uw[4][4]; float bsv[4];
#pragma unroll
    for (int tb = 0; tb < 4; ++tb) { const int t = tb * 32 + r32; const bf16_t* wrow = Wm + ((size_t)g * 128 + t) * 128 + hi * 8;
#pragma unroll
        for (int ks = 0; ks < 8; ++ks) if (ks < 2 * tb + 2) bfr[tb][ks] = *(const bf16x8*)(wrow + ks * 16);
        bsv[tb] = sb[g * 128 + t];
#pragma unroll
        for (int rg = 0; rg < 4; ++rg) uw[tb][rg] = *(const u32x2*)(H + (rowbase + t) * HW + C_U + g * 64 + db * 32 + 8 * rg + 4 * hi); }
#pragma unroll
    for (int tb = 0; tb < 4; ++tb) {
        f32x16 acc;
#pragma unroll
        for (int r = 0; r < 16; ++r) acc[r] = 0.f;
        const int t = tb * 32 + r32;
#pragma unroll
        for (int ks = 0; ks < 8; ++ks) if (ks < 2 * tb + 2) { const bf16x8 a = *(const LAS bf16x8*)(ab + ks * 32); acc = __builtin_amdgcn_mfma_f32_32x32x16_bf16(a, bfr[tb][ks], acc, 0, 0, 0); }
        const float bs = bsv[tb];
#pragma unroll
        for (int rg = 0; rg < 4; ++rg) { const int d4 = g * 64 + db * 32 + 8 * rg + 4 * hi; const u32x2 u2 = uw[tb][rg];
            u32x2 ow; ow.x = pk2(bflo(u2.x) * (acc[4 * rg] + bs), bfhi(u2.x) * (acc[4 * rg + 1] + bs)); ow.y = pk2(bflo(u2.y) * (acc[4 * rg + 2] + bs), bfhi(u2.y) * (acc[4 * rg + 3] + bs));
            *(u32x2*)(Y + (rowbase + t) * DM + 768 + d4) = ow; }
    }
    __syncthreads();
}

__device__ __forceinline__ void shortconv_items(const Params& p, int l, const bf16_t* __restrict__ H, bf16_t* __restrict__ Y, int gtid, int NTHR) {
    const float* cw = p.in[I_CONV_MIX_W] + l * 3 * 256;
#pragma unroll 2
    for (int it = gtid; it < (M / 2) * 32; it += NTHR) {
        const int cgp = it & 31, rp = it >> 5, t0 = 2 * rp, c0 = cgp * 8;
        float w0[8], w1[8], w2[8];
        { const f32x4 a0 = *(const f32x4*)(cw + c0), a1 = *(const f32x4*)(cw + c0 + 4), b0 = *(const f32x4*)(cw + 256 + c0), b1 = *(const f32x4*)(cw + 256 + c0 + 4), d0 = *(const f32x4*)(cw + 512 + c0), d1 = *(const f32x4*)(cw + 512 + c0 + 4);
#pragma unroll
          for (int e = 0; e < 4; ++e) { w0[e] = a0[e]; w0[4 + e] = a1[e]; w1[e] = b0[e]; w1[4 + e] = b1[e]; w2[e] = d0[e]; w2[4 + e] = d1[e]; } }
        float z[4][8];
        const bool head = (t0 % SEQ) == 0;
#pragma unroll
        for (int r = 0; r < 4; ++r) { const int tr = t0 - 2 + r;
            if (r < 2 && head) {
#pragma unroll
                for (int e = 0; e < 8; ++e) z[r][e] = 0.f; }
            else { float a[8], b[8]; unpack8(*(const u32x4*)(H + (size_t)tr * HW + C_CG + c0), a); unpack8(*(const u32x4*)(H + (size_t)tr * HW + C_HC + c0), b);
#pragma unroll
                for (int e = 0; e < 8; ++e) z[r][e] = a[e] * b[e]; } }
#pragma unroll
        for (int r = 0; r < 2; ++r) { float bg[8]; unpack8(*(const u32x4*)(H + (size_t)(t0 + r) * HW + C_BG + c0), bg); float o[8];
#pragma unroll
            for (int e = 0; e < 8; ++e) o[e] = bg[e] * (w0[e] * z[r][e] + w1[e] * z[r + 1][e] + w2[e] * z[r + 2][e]);
            pg8::store8(Y + (size_t)(t0 + r) * DM + 512 + c0, (f32x4){o[0], o[1], o[2], o[3]}, (f32x4){o[4], o[5], o[6], o[7]}); }
    }
}

__device__ __forceinline__ void convact_items(const Params& p, int l, const bf16_t* __restrict__ H2, bf16_t* __restrict__ ACT, int gtid, int NTHR) {
    const float* cw = p.in[I_CONV_FFN_W] + (size_t)l * 3 * DFF2;
    constexpr int NCG = DFF / 8;
    for (int it = gtid; it < (M / 8) * NCG; it += NTHR) {
        const int cgp = it % NCG, rgp = it / NCG, t0 = rgp * 8, c0 = cgp * 8;
        float wa[3][8], wb[3][8];
#pragma unroll
        for (int k = 0; k < 3; ++k)
#pragma unroll
            for (int e = 0; e < 8; ++e) { wa[k][e] = cw[k * DFF2 + c0 + e]; wb[k][e] = cw[k * DFF2 + DFF + c0 + e]; }
        float a0[8], a1[8], b0[8], b1[8];
        if ((t0 % SEQ) == 0) {
#pragma unroll
            for (int e = 0; e < 8; ++e) { a0[e] = 0.f; a1[e] = 0.f; b0[e] = 0.f; b1[e] = 0.f; } }
        else { unpack8(*(const u32x4*)(H2 + (size_t)(t0 - 2) * DFF2 + c0), a0); unpack8(*(const u32x4*)(H2 + (size_t)(t0 - 1) * DFF2 + c0), a1);
               unpack8(*(const u32x4*)(H2 + (size_t)(t0 - 2) * DFF2 + DFF + c0), b0); unpack8(*(const u32x4*)(H2 + (size_t)(t0 - 1) * DFF2 + DFF + c0), b1); }
#pragma unroll
        for (int r = 0; r < 8; ++r) { float a2[8], b2[8];
            unpack8(*(const u32x4*)(H2 + (size_t)(t0 + r) * DFF2 + c0), a2); unpack8(*(const u32x4*)(H2 + (size_t)(t0 + r) * DFF2 + DFF + c0), b2);
            float o[8];
#pragma unroll
            for (int e = 0; e < 8; ++e) { const float ca = wa[0][e] * a0[e] + wa[1][e] * a1[e] + wa[2][e] * a2[e]; const float cb = wb[0][e] * b0[e] + wb[1][e] * b1[e] + wb[2][e] * b2[e];
                o[e] = gelu_t(ca) * cb; a0[e] = a1[e]; a1[e] = a2[e]; b0[e] = b1[e]; b1[e] = b2[e]; }
            pg8::store8(ACT + (size_t)(t0 + r) * DFF + c0, (f32x4){o[0], o[1], o[2], o[3]}, (f32x4){o[4], o[5], o[6], o[7]}); }
    }
}


__device__ __forceinline__ void conv_fixup(const Params& p, int l, const bf16_t* HALO, bf16_t* ACT, int pm) {
    if ((pm & 15) == 0) return;
    const int t = ltid(); const float* cw = p.in[I_CONV_FFN_W] + (size_t)l * 3 * DFF2;
    if (t < DFF / 8) { const int c0 = t * 8;
        float o0[8], o1[8], av[2][8], bv[2][8];
#pragma unroll
        for (int half = 0; half < 2; ++half) { const int cc = half * DFF + c0;
            float r0[8], r1[8], p254[8], p255[8];
            unpack8(*(const u32x4*)(HALO + ((size_t)pm * 4 + 0) * DFF2 + cc), r0); unpack8(*(const u32x4*)(HALO + ((size_t)pm * 4 + 1) * DFF2 + cc), r1);
            unpack8(*(const u32x4*)(HALO + ((size_t)(pm - 1) * 4 + 2) * DFF2 + cc), p254); unpack8(*(const u32x4*)(HALO + ((size_t)(pm - 1) * 4 + 3) * DFF2 + cc), p255);
#pragma unroll
            for (int e = 0; e < 8; ++e) { const float w0 = cw[cc + e], w1 = cw[DFF2 + cc + e], w2 = cw[2 * DFF2 + cc + e];
                const float c_0 = w2 * r0[e] + w1 * p255[e] + w0 * p254[e], c_1 = w2 * r1[e] + w1 * r0[e] + w0 * p255[e];
                if (half == 0) { av[0][e] = c_0; av[1][e] = c_1; } else { bv[0][e] = c_0; bv[1][e] = c_1; } } }
#pragma unroll
        for (int e = 0; e < 8; ++e) { o0[e] = gelu_t(av[0][e]) * bv[0][e]; o1[e] = gelu_t(av[1][e]) * bv[1][e]; }
        pg8::store8(ACT + (size_t)(pm * 256) * DFF + c0, (f32x4){o0[0], o0[1], o0[2], o0[3]}, (f32x4){o0[4], o0[5], o0[6], o0[7]});
        pg8::store8(ACT + (size_t)(pm * 256 + 1) * DFF + c0, (f32x4){o1[0], o1[1], o1[2], o1[3]}, (f32x4){o1[4], o1[5], o1[6], o1[7]}); }
    asm volatile("s_waitcnt vmcnt(0)" ::: "memory");
    __syncthreads();
}

#define XB_TMO      128
#define XB_XCNT(j)  (256  + 64 * (j))
#define XB_XSUB(j)  (1280 + 64 * (j))
#define XB_XGEN(j)  (2304 + 64 * (j))
#define XB_TOP      3328
#define XB_TOPGEN   3392
#define XCD_BAR_WORDS 3456
#define XB_SPIN_CAP (1u << 22)
__device__ __forceinline__ unsigned xb_ld(unsigned* p)              { return __hip_atomic_load(p, __ATOMIC_RELAXED, __HIP_MEMORY_SCOPE_AGENT); }
__device__ __forceinline__ unsigned xb_add(unsigned* p, unsigned v) { return __hip_atomic_fetch_add(p, v, __ATOMIC_RELAXED, __HIP_MEMORY_SCOPE_AGENT); }
__device__ __forceinline__ unsigned xb_xcc_id() { return (unsigned)__builtin_amdgcn_s_getreg((3 << 11) | 20) & 0xFu; }
#define XB_SPIN(cond, bar) do { unsigned _sp = 0; while (cond) { __builtin_amdgcn_s_sleep(1); \
    if ((++_sp & 255u) == 0u) { if (xb_ld(&(bar)[XB_TMO])) break; if (_sp > XB_SPIN_CAP) { atomicAdd(&(bar)[XB_TMO], 1u); break; } } } } while (0)
struct XcdBarrier { unsigned* bar; unsigned x; volatile LAS unsigned* st; };
__device__ __forceinline__ XcdBarrier xcd_barrier_post(unsigned* bar, volatile LAS unsigned* st) {
    XcdBarrier b; b.bar = bar; b.x = xb_xcc_id(); b.st = st;
    if (threadIdx.x == 0) (void)xb_add(&bar[XB_XCNT(b.x)], 1u);
    return b;
}
__device__ __forceinline__ void xcd_barrier_complete(unsigned* bar, unsigned x, unsigned& nloc, unsigned& nx) {
    const unsigned G = gridDim.x * gridDim.y * gridDim.z;
    unsigned sum, cnt, mine, sp = 0u;
    for (;;) {
        sum = 0u; cnt = 0u; mine = 0u;
#pragma unroll
        for (unsigned j = 0; j < 16; ++j) { const unsigned c = xb_ld(&bar[XB_XCNT(j)]); sum += c; cnt += (c > 0u) ? 1u : 0u; mine = (j == x) ? c : mine; }
        if (sum == G) break;
        __builtin_amdgcn_s_sleep(1);
        if ((++sp & 255u) == 0u) { if (xb_ld(&bar[XB_TMO])) break; if (sp > XB_SPIN_CAP) { atomicAdd(&bar[XB_TMO], 1u); break; } }
    }
    nloc = mine > 0u ? mine : 1u; nx = cnt > 0u ? cnt : 1u;
}
__device__ __forceinline__ void xcd_barrier(const XcdBarrier& b) {
    asm volatile("s_waitcnt vmcnt(0)" ::: "memory");
    __syncthreads();
    if (threadIdx.x == 0) {
        unsigned* bar = b.bar;
        __builtin_amdgcn_s_waitcnt(0);
        unsigned nloc = b.st[0], nx = b.st[1];
        if (nloc == 0u) { xcd_barrier_complete(bar, b.x, nloc, nx); b.st[0] = nloc; b.st[1] = nx; }
        const unsigned old = xb_add(&bar[XB_XSUB(b.x)], 1u);
        const unsigned gen = old / nloc;
        if (old + 1u == (gen + 1u) * nloc) {
            __builtin_amdgcn_fence(__ATOMIC_RELEASE, "agent");
            asm volatile("s_waitcnt vmcnt(0)" ::: "memory");
            const unsigned og = xb_add(&bar[XB_TOP], 1u);
            const unsigned tg = og / nx;
            if (og + 1u == (tg + 1u) * nx) xb_add(&bar[XB_TOPGEN], 1u);
            else XB_SPIN(xb_ld(&bar[XB_TOPGEN]) == tg, bar);
            __builtin_amdgcn_fence(__ATOMIC_ACQUIRE, "agent");
            xb_add(&bar[XB_XGEN(b.x)], 1u);
            asm volatile("s_waitcnt vmcnt(0)" ::: "memory");
        } else {
            XB_SPIN(xb_ld(&bar[XB_XGEN(b.x)]) == gen, bar);
            __builtin_amdgcn_fence(__ATOMIC_ACQUIRE, "agent");
            asm volatile("s_waitcnt vmcnt(0)" ::: "memory");
        }
    }
    __syncthreads();
}
constexpr int EX_OFF = 131072 + 1024;
constexpr int MISC_OFF = 131072 + 512;
constexpr size_t WS_BAR = 65536;

__global__ void __launch_bounds__(512, 2) fwd_megakernel(Params p_unused) {
    extern __shared__ __attribute__((aligned(16))) unsigned char lds_raw[];
    cg::grid_group grid = cg::this_grid();
    LAS unsigned char* lds = (LAS unsigned char*)lds_raw;
    LAS float* wfl = (LAS float*)lds;
    (void)p_unused;
    if (threadIdx.x < 64) ((LAS unsigned*)(lds + MISC_OFF))[threadIdx.x] = 0u;
    __syncthreads();
    { auto kz = __builtin_amdgcn_kernarg_segment_ptr(); unsigned char* wz = ((const Params*)kz)->ws; const int gz = blockIdx.x * 512 + threadIdx.x;
      if (gz < (384 - 64) * 1024 / 16) ((u32x4*)(wz + 65536))[gz] = (u32x4){0u, 0u, 0u, 0u}; }
    grid.sync();
    { auto ka0 = __builtin_amdgcn_kernarg_segment_ptr(); const Params& p0 = *(const Params*)ka0; (void)xcd_barrier_post((unsigned*)(p0.ws + WS_BAR), (volatile LAS unsigned*)(lds + MISC_OFF)); }
#define GRID_BAR() do { auto kb_ = __builtin_amdgcn_kernarg_segment_ptr(); asm volatile("" : "+s"(kb_)); XcdBarrier b_; b_.bar = (unsigned*)(((const Params*)kb_)->ws + WS_BAR); b_.x = xb_xcc_id(); \
        b_.st = (volatile LAS unsigned*)(lds + MISC_OFF); xcd_barrier(b_); } while (0)
#define PHASE_BEGIN \
    auto ka_ = __builtin_amdgcn_kernarg_segment_ptr(); asm volatile("" : "+s"(ka_)); \
    const Params& p = *(const Params*)ka_; \
    int l = l_loop; asm volatile("" : "+s"(l)); \
    const int tid = ltid(), lane = tid & 63, wave = __builtin_amdgcn_readfirstlane(tid >> 6); \
    int G = gridDim.x, bx = blockIdx.x; asm volatile("" : "+s"(G), "+s"(bx)); \
    const int gw = bx * 8 + wave, NGW = G * 8, gtid = bx * 512 + tid, NTHR = G * 512; \
    unsigned char* ws = p.ws; float* LF = (float*)(ws + WS_LF); float* RS = (float*)(ws + WS_RS); (void)RS; \
    bf16_t* Win = (bf16_t*)(ws + WS_WIN); bf16_t* Wbr = (bf16_t*)(ws + WS_WBR); bf16_t* Wout = (bf16_t*)(ws + WS_WOUT); const size_t ffo = (l & 1) ? (WS_FFN2 - WS_WUP) : 0; bf16_t* Wup = (bf16_t*)(ws + WS_WUP + ffo); bf16_t* Wdn = (bf16_t*)(ws + WS_WDN + ffo); bf16_t* Wm = (bf16_t*)(ws + WS_WM + ffo); \
    bf16_t* XN = (bf16_t*)(ws + WS_XN); bf16_t* Y = (bf16_t*)(ws + WS_Y); bf16_t* MG = (bf16_t*)(ws + WS_MG); bf16_t* ACT = (bf16_t*)(ws + WS_ACT); \
    bf16_t* Vt = (bf16_t*)(ws + WS_VT); bf16_t* H = (bf16_t*)(ws + WS_H); bf16_t* H2 = H; bf16_t* YO = H; float* xres = p.out; \
    (void)l; (void)lane; (void)gw; (void)NGW; (void)gtid; (void)NTHR; (void)LF; (void)Win; (void)Wbr; (void)Wout; (void)Wup; (void)Wdn; (void)Wm; (void)XN; (void)Y; (void)MG; (void)ACT; (void)Vt; (void)H; (void)H2; (void)YO; (void)xres;

    { const int l_loop = 0; PHASE_BEGIN
      row_phase<true, false, true, false, false>(p.in[I_X], nullptr, nullptr, XN, RS, nullptr, nullptr, nullptr, nullptr, gw, NGW, lane);
      convert_weights<7>(p, 0, lds, gw, NGW, lane, wave); }
    GRID_BAR();

    for (int l_loop = 0; l_loop < DEPTH; ++l_loop) {
        { PHASE_BEGIN pg8::SchedIn S{XN, Win, G, bx}; pg8::EpiIn E{H, Vt, p.in[I_B_GATE] + l * 3 * DM, RS, LF, p.in[I_B_FORGET] + l * 8};
          pg8::gemm_phase<pg8::EpiIn, pg8::SchedIn, true>(lds, DM, DM, S, E); }
        GRID_BAR();
        { PHASE_BEGIN
          for (int u = bx; u < 256; u += G) { const int bh = (u & 7) * 4 + (u >> 6), s = (u >> 3) & 7;     attn_unit(lds, H, Vt, LF, Y, bh >> 3, bh & 7, s, true); attn_unit(lds, H, Vt, LF, Y, bh >> 3, bh & 7, 15 - s, false); }
          __syncthreads();
          for (int u = bx; u < 128; u += G) sgu_unit(lds, p, l, H, Wm, Y, u);
          shortconv_items(p, l, H, Y, gtid, NTHR);
 }
        GRID_BAR();
        { PHASE_BEGIN pg8::SchedBr S{Y, Wbr, G, bx}; pg8::EpiBr E{H, MG};
          pg8::gemm_phase<pg8::EpiBr, pg8::SchedBr, true>(lds, DM, DM, S, E); }
        GRID_BAR();
        { PHASE_BEGIN pg8::SchedPlain S{MG, Wout, DM, DM, 64, 4, 16, G, bx};
          unsigned* cb = (unsigned*)(ws + WS_CNT) + (size_t)(4 * l) * 4096;
          const pg8::PanelSum s1{(float*)(ws + WS_X1), cb}, s2{(float*)(ws + WS_X2), cb + 4096};
          { pg8::EpiResNorm<false, false> E{nullptr, XN, p.in[I_POST_MIX_G] + l * DM, RS, nullptr, s1, s2}; pg8::gemm_phase<pg8::EpiResNorm<false, false>, pg8::SchedPlain, false>(lds, DM, DM, S, E); } }
        GRID_BAR();
        { PHASE_BEGIN pg8::SchedPlain S{XN, Wup, DM, DM, 64, 22, 16, G, bx}; pg8::EpiConv E{ACT, (bf16_t*)(ws + WS_HALO), p.in[I_CONV_FFN_W] + (size_t)l * 3 * DFF2, RS, lds + EX_OFF};
          pg8::gemm_phase<pg8::EpiConv, pg8::SchedPlain, true, true>(lds, DM, DM, S, E);
          if (G == 256 && bx >= 128 && l + 1 < DEPTH) convert_weights<7>(p, l + 1, lds, (bx - 128) * 8 + wave, 128 * 8, lane, wave); }
        GRID_BAR();
        { PHASE_BEGIN pg8::SchedPlain S{ACT, Wdn, DFF, DFF, 64, 4, 44, G, bx};
          { pg8::Unit u0; if (S.next(0, u0)) conv_fixup(p, l, (const bf16_t*)(ws + WS_HALO), ACT, u0.pm); }
          unsigned* cb = (unsigned*)(ws + WS_CNT) + (size_t)(4 * l + 2) * 4096;
          const pg8::PanelSum s1{(float*)(ws + WS_X1), cb}, s2{(float*)(ws + WS_X2), cb + 4096};
          if (l + 1 < DEPTH) { pg8::EpiResNorm<false, false> E{nullptr, XN, p.in[I_POST_FFN_G] + l * DM, RS, nullptr, s1, s2}; pg8::gemm_phase<pg8::EpiResNorm<false, false>, pg8::SchedPlain, false>(lds, DFF, DFF, S, E); }
          else { pg8::EpiResNorm<false, true> E{nullptr, XN, p.in[I_POST_FFN_G] + l * DM, nullptr, xres, s1, s2}; pg8::gemm_phase<pg8::EpiResNorm<false, true>, pg8::SchedPlain, false>(lds, DFF, DFF, S, E); } }
        if (l_loop + 1 < DEPTH) {
            GRID_BAR();
            if (gridDim.x != 256) { { PHASE_BEGIN convert_weights<7>(p, l + 1, lds, gw, NGW, lane, wave); } GRID_BAR(); }
        }
    }
#undef PHASE_BEGIN
#undef GRID_BAR
}

extern "C" void kernel_launch(void* const* d_in, const int* in_sizes, int n_in, void* d_out, int out_size, void* d_ws, size_t ws_size, hipStream_t stream) {
    static int grid = 0;
    if (grid == 0) {
        if (n_in != 20 || out_size != M * DM || ws_size < WS_END) { fprintf(stderr, "kernel_launch: unexpected problem (n_in %d, out %d, ws %zu)\n", n_in, out_size, ws_size); grid = -1; return; }
        int dev = 0, cus = 0, per_cu = 0;
        hipGetDevice(&dev); hipDeviceGetAttribute(&cus, hipDeviceAttributeMultiprocessorCount, dev);
        if (hipFuncSetAttribute((const void*)fwd_megakernel, hipFuncAttributeMaxDynamicSharedMemorySize, LDS_BYTES) != hipSuccess) { fprintf(stderr, "kernel_launch: hipFuncSetAttribute failed\n"); grid = -1; return; }
        hipOccupancyMaxActiveBlocksPerMultiprocessor(&per_cu, (const void*)fwd_megakernel, 512, LDS_BYTES);
        if (per_cu < 1) { fprintf(stderr, "kernel_launch: occupancy query says %d blocks per CU\n", per_cu); per_cu = 1; }
        (void)hipGetLastError();
        grid = cus;
    }
    if (grid < 0) return;
    Params p{};
    for (int i = 0; i < 20; ++i) p.in[i] = (const float*)d_in[i];
    p.out = (float*)d_out; p.ws = (unsigned char*)d_ws;
    void* args[] = {&p};
    hipError_t e = hipLaunchCooperativeKernel((const void*)fwd_megakernel, dim3(grid), dim3(512), args, LDS_BYTES, stream);
    if (e != hipSuccess) fprintf(stderr, "cooperative launch failed: %s (grid %d)\n", hipGetErrorString(e), grid);
}
```
